# Optimizing an MI355X kernel written in HIP

```python
import math
import jax, jax.numpy as jnp
from jax import lax
import numpy as np

D_MODEL = 1024
BATCH = 4
SEQ = 4096
DEPTH = 1

CHUNK = 64
Q_BLOCK = 128
SB_HEADS = 8
SB_HEAD_DIM = 64
DA_HEADS = 4
DA_HEAD_DIM = 64
SB_WIDTH = SB_HEADS * SB_HEAD_DIM
DA_WIDTH = DA_HEADS * 2 * DA_HEAD_DIM
IN_WIDTH = 3 * SB_WIDTH + 3 * DA_WIDTH
N_BRANCH = 2
ROPE_THETA = 500000.0
ROPE_DIM = DA_HEAD_DIM // 4
D_FF = ((8 * D_MODEL // 3 + 255) // 256) * 256
EPS = 1e-6
NEG_INF = -1e30

kernel_name = "hybrid_stickbreak_diffattn_gated_block"


def _rmsnorm(x, g):
    xf = x.astype(jnp.float32)
    y = xf * lax.rsqrt(jnp.mean(xf * xf, axis=-1, keepdims=True) + EPS) * g.astype(jnp.float32)
    return y.astype(x.dtype)


def _heads(t, n_heads):
    b, s, _ = t.shape
    return t.reshape(b, s, n_heads, -1).transpose(0, 2, 1, 3)


def _merge_heads(t):
    b, h, s, d = t.shape
    return t.transpose(0, 2, 1, 3).reshape(b, s, h * d)


def _to_blocks(t):
    b, h, s, d = t.shape
    return t.reshape(b, h, s // Q_BLOCK, Q_BLOCK, d).transpose(2, 0, 1, 3, 4)


def _from_blocks(t):
    nb, b, h, qb, d = t.shape
    return t.transpose(1, 2, 0, 3, 4).reshape(b, h, nb * qb, d)


def _partial_rope(t):
    s = t.shape[2]
    pos = jnp.arange(s, dtype=jnp.float32)
    inv_freq = ROPE_THETA ** (-jnp.arange(0, ROPE_DIM, 2, dtype=jnp.float32) / ROPE_DIM)
    ang = pos[:, None] * inv_freq[None, :]
    cos, sin = jnp.cos(ang), jnp.sin(ang)
    tf = t.astype(jnp.float32)
    half = ROPE_DIM // 2
    x1, x2, rest = tf[..., :half], tf[..., half:ROPE_DIM], tf[..., ROPE_DIM:]
    rot = jnp.concatenate([x1 * cos - x2 * sin, x2 * cos + x1 * sin, rest], axis=-1)
    return rot.astype(t.dtype)


def _stick_breaking_attention(q, k, v):
    s_len = q.shape[2]
    nb = s_len // Q_BLOCK
    scale = q.shape[-1] ** -0.5
    kf = k.astype(jnp.float32)
    vf = v.astype(jnp.float32)
    kpos = jnp.arange(s_len)

    def one_block(args):
        qb, t0 = args
        tpos = t0 + jnp.arange(Q_BLOCK)
        mask = kpos[None, :] < tpos[:, None]
        z = jnp.einsum('bhqd,bhkd->bhqk', qb.astype(jnp.float32), kf) * scale
        log_1mb = jnp.where(mask, jax.nn.log_sigmoid(-z), 0.0)
        between = lax.cumsum(log_1mb, axis=3, reverse=True) - log_1mb
        a = jnp.where(mask, jnp.exp(jax.nn.log_sigmoid(z) + between), 0.0)
        return jnp.einsum('bhqk,bhkd->bhqd', a, vf)

    out = lax.map(one_block, (_to_blocks(q), jnp.arange(nb) * Q_BLOCK))
    return _from_blocks(out).astype(v.dtype)


def _diff_attention(q1, q2, k1, k2, v, lam):
    s_len = q1.shape[2]
    nb = s_len // Q_BLOCK
    scale = q1.shape[-1] ** -0.5
    k1f, k2f, vf = k1.astype(jnp.float32), k2.astype(jnp.float32), v.astype(jnp.float32)
    kchunk = jnp.arange(s_len) // CHUNK
    lamf = lam.astype(jnp.float32)

    def one_block(args):
        q1b, q2b, t0 = args
        tchunk = (t0 + jnp.arange(Q_BLOCK)) // CHUNK
        mask = kchunk[None, :] <= tchunk[:, None]
        s1 = jnp.einsum('bhqd,bhkd->bhqk', q1b.astype(jnp.float32), k1f) * scale
        s2 = jnp.einsum('bhqd,bhkd->bhqk', q2b.astype(jnp.float32), k2f) * scale
        p1 = jax.nn.softmax(jnp.where(mask, s1, NEG_INF), axis=-1)
        p2 = jax.nn.softmax(jnp.where(mask, s2, NEG_INF), axis=-1)
        return jnp.einsum('bhqk,bhkd->bhqd', p1 - lamf * p2, vf)

    out = lax.map(one_block, (_to_blocks(q1), _to_blocks(q2), jnp.arange(nb) * Q_BLOCK))
    return _from_blocks(out).astype(v.dtype)


def setup_inputs(seed: int = 0) -> dict:
    key = jax.random.key(seed)
    ks = jax.random.split(key, 20)
    L = DEPTH

    def w(k, shape, fan_in):
        return jax.random.normal(k, shape, jnp.float32) * fan_in ** -0.5

    def gain(k, shape):
        return 1.0 + 0.02 * jax.random.normal(k, shape, jnp.float32)

    return {
        "x": jax.random.normal(ks[0], (BATCH, SEQ, D_MODEL), jnp.float32),
        "g_mix": gain(ks[1], (L, D_MODEL)),
        "w_in": w(ks[2], (L, D_MODEL, IN_WIDTH), D_MODEL),
        "g_q": gain(ks[3], (L, DA_HEAD_DIM)),
        "g_k": gain(ks[4], (L, DA_HEAD_DIM)),
        "lam_q1": 0.1 * jax.random.normal(ks[5], (L, DA_HEAD_DIM), jnp.float32),
        "lam_k1": 0.1 * jax.random.normal(ks[6], (L, DA_HEAD_DIM), jnp.float32),
        "lam_q2": 0.1 * jax.random.normal(ks[7], (L, DA_HEAD_DIM), jnp.float32),
        "lam_k2": 0.1 * jax.random.normal(ks[8], (L, DA_HEAD_DIM), jnp.float32),
        "g_sub": gain(ks[9], (L, 2 * DA_HEAD_DIM)),
        "w_branch_a": w(ks[10], (L, SB_WIDTH, D_MODEL), SB_WIDTH),
        "w_branch_b": w(ks[11], (L, DA_WIDTH, D_MODEL), DA_WIDTH),
        "w_gate": w(ks[12], (L, D_MODEL, N_BRANCH * D_MODEL), D_MODEL),
        "b_gate": 0.02 * jax.random.normal(ks[13], (L, N_BRANCH * D_MODEL), jnp.float32),
        "w_out": w(ks[14], (L, D_MODEL, D_MODEL), D_MODEL),
        "g_ffn": gain(ks[15], (L, D_MODEL)),
        "w_ffn_gate": w(ks[16], (L, D_MODEL, D_FF), D_MODEL),
        "w_ffn_up": w(ks[17], (L, D_MODEL, D_FF), D_MODEL),
        "w_ffn_down": w(ks[18], (L, D_FF, D_MODEL), D_FF),
    }


def reference(x, g_mix, w_in, g_q, g_k, lam_q1, lam_k1, lam_q2, lam_k2, g_sub,
              w_branch_a, w_branch_b, w_gate, b_gate, w_out, g_ffn,
              w_ffn_gate, w_ffn_up, w_ffn_down):
    b, s, _ = x.shape
    for layer in range(DEPTH):
        lambda_init = 0.8 - 0.6 * math.exp(-0.3 * layer)

        h = _rmsnorm(x, g_mix[layer])
        proj = jnp.einsum('bsd,de->bse', h, w_in[layer])
        sb_q, sb_k, sb_v, da_q, da_k, da_v = jnp.split(
            proj, np.cumsum([SB_WIDTH, SB_WIDTH, SB_WIDTH, DA_WIDTH, DA_WIDTH]).tolist(), axis=-1)

        o_a = _stick_breaking_attention(_heads(sb_q, SB_HEADS), _heads(sb_k, SB_HEADS),
                                        _heads(sb_v, SB_HEADS))
        o_a = _merge_heads(o_a)

        qh = _heads(da_q, DA_HEADS)
        kh = _heads(da_k, DA_HEADS)
        vh = _heads(da_v, DA_HEADS)
        q1 = _partial_rope(_rmsnorm(qh[..., :DA_HEAD_DIM], g_q[layer]))
        q2 = _partial_rope(_rmsnorm(qh[..., DA_HEAD_DIM:], g_q[layer]))
        k1 = _partial_rope(_rmsnorm(kh[..., :DA_HEAD_DIM], g_k[layer]))
        k2 = _partial_rope(_rmsnorm(kh[..., DA_HEAD_DIM:], g_k[layer]))
        lam = (jnp.exp(jnp.sum(lam_q1[layer].astype(jnp.float32) * lam_k1[layer].astype(jnp.float32)))
               - jnp.exp(jnp.sum(lam_q2[layer].astype(jnp.float32) * lam_k2[layer].astype(jnp.float32)))
               + lambda_init)
        o_b = _diff_attention(q1, q2, k1, k2, vh, lam)
        o_b = _rmsnorm(o_b, g_sub[layer]) * (1.0 - lambda_init)
        o_b = _merge_heads(o_b.astype(x.dtype))

        gates = jax.nn.sigmoid(jnp.einsum('bsd,de->bse', h, w_gate[layer]) + b_gate[layer])
        gates = gates.reshape(b, s, N_BRANCH, D_MODEL)
        br_a = jnp.einsum('bsc,cd->bsd', o_a, w_branch_a[layer])
        br_b = jnp.einsum('bsc,cd->bsd', o_b, w_branch_b[layer])
        merged = gates[:, :, 0] * br_a + gates[:, :, 1] * br_b
        x = x + jnp.einsum('bsd,de->bse', merged, w_out[layer])

        h2 = _rmsnorm(x, g_ffn[layer])
        ff = jax.nn.silu(jnp.einsum('bsd,df->bsf', h2, w_ffn_gate[layer])) * \
            jnp.einsum('bsd,df->bsf', h2, w_ffn_up[layer])
        x = x + jnp.einsum('bsf,fd->bsd', ff, w_ffn_down[layer])
    return x
```

```cpp
#include <hip/hip_runtime.h>
#include <hip/hip_cooperative_groups.h>
#include <cstdio>
#include <cstdint>
#include <cmath>
namespace pg8 {
#define PG8_LAS __attribute__((address_space(3)))
typedef unsigned short bf16_t;
typedef short bf16x8 __attribute__((ext_vector_type(8)));
typedef float f32x4 __attribute__((ext_vector_type(4)));
typedef unsigned u32x4 __attribute__((ext_vector_type(4)));
constexpr int BM = 256, BK = 64, HALF = 128, HTB = HALF * BK * 2  , STAGE_BYTES = 8 * HTB, NXCD = 8, WGM = 8;

__host__ __device__ __forceinline__ int lds_byte(int r, int c) { const int st = (r >> 4) * 2 + (c >> 5), rr = r & 15, cc = c & 31, ob = rr * 64 + cc * 2; return st * 1024 + (ob ^ (((ob >> 9) & 1) << 5)); }
__host__ __device__ __forceinline__ void stage_rc(int b, int& R, int& C) { const int st = b / 1024, sb = b % 1024, swz = sb ^ (((sb >> 9) & 1) << 5); R = (st >> 1) * 16 + swz / 64; C = (st & 1) * 32 + (swz % 64) / 2; }
__host__ __device__ __forceinline__ int perm32(int rho) { const int n = rho >> 4, i = rho & 15; return 8 * (i >> 2) + 4 * n + (i & 3); }

struct Unit { int pm, pn; };
struct Gemm { const bf16_t* A; const bf16_t* Bt; int M, N, K; };

struct StaticOrder {
    int nM, nN, nwg, G, c;
    __host__ __device__ void init(int M, int N, int G_, int c_) { nM = M / BM; nN = N / BM; nwg = nM * nN; G = G_; c = c_; }
    __host__ __device__ bool next(int i, Unit& u) const {
        const long L = (long)i * G + c; if (L >= nwg) return false;
        int wgid = (int)L; { const int q = nwg / NXCD, r = nwg % NXCD, xcd = wgid % NXCD, off = wgid / NXCD; wgid = (xcd < r ? xcd * (q + 1) : r * (q + 1) + (xcd - r) * q) + off; }
        const int nig = WGM * nN, gid = wgid / nig, fm = gid * WGM, gsz = (nM - fm) < WGM ? (nM - fm) : WGM;
        u.pm = fm + ((wgid % nig) % gsz); u.pn = (wgid % nig) / gsz; return true;
    }
    __device__ __forceinline__ void a_ready(const Unit&) const {}
    __device__ __forceinline__ void done(const Unit&) const {}
};

typedef __bf16 bf16x2_cv __attribute__((ext_vector_type(2))); typedef float f32x2_cv __attribute__((ext_vector_type(2)));
__device__ __forceinline__ unsigned cvt_pk_bf16(float lo, float hi) { f32x2_cv v = {lo, hi}; bf16x2_cv b = __builtin_convertvector(v, bf16x2_cv); return __builtin_bit_cast(unsigned, b); }
typedef float f32x2 __attribute__((ext_vector_type(2)));
typedef unsigned u32x2 __attribute__((ext_vector_type(2)));
__device__ __forceinline__ float bf_lo(unsigned w) { return __uint_as_float(w << 16); }
__device__ __forceinline__ float bf_hi(unsigned w) { return __uint_as_float(w & 0xffff0000u); }
__device__ __forceinline__ float sigmoidf_fast(float x) { return __builtin_amdgcn_rcpf(1.0f + __builtin_amdgcn_exp2f(-1.4426950408889634f * x)); }
constexpr float QC2 = 0.125f * 1.4426950408889634f;
constexpr int PROJ_PITCH = 3072, GATE_PITCH = 2048;

struct EpiProj {
    static constexpr bool PERM = true, AFTER_DRAIN = false, MIDHOOK = false;
    bf16_t* proj; bf16_t* gates; const float* bgate; const float* gq; const float* gk; const float* rope;
    __device__ __forceinline__ void operator()(const f32x4 (&acc)[2][2][4][2], const Unit& u, int wr, int wc, int fr, int fq) const {
        const int row0 = u.pm * BM + wr * 64 + fr, pn = u.pn;
        const int lcol = pn * 256 + 64 * wc + 8 * fq;
        if (pn >= 12) {
            const int ch0 = (pn - 12) * 128 + 32 * wc + 8 * fq;
            f32x4 bv[2][2];
#pragma unroll
            for (int bj = 0; bj < 2; ++bj)
#pragma unroll
                for (int n = 0; n < 2; ++n) bv[bj][n] = *(const f32x4*)(bgate + bj * 1024 + ch0 + 4 * n);
#pragma unroll
            for (int ai = 0; ai < 2; ++ai)
#pragma unroll
                for (int m = 0; m < 4; ++m) { bf16_t* rowp = gates + (size_t)(row0 + ai * HALF + m * 16) * GATE_PITCH + ch0;
                    float rr[8], gg[8];
#pragma unroll
                    for (int n = 0; n < 2; ++n)
#pragma unroll
                        for (int i = 0; i < 4; ++i) {
                            const float d0 = 1.0f + __builtin_fminf(__builtin_amdgcn_exp2f(-1.4426950408889634f * (acc[ai][0][m][n][i] + bv[0][n][i])), 1e18f);
                            const float d1 = 1.0f + __builtin_fminf(__builtin_amdgcn_exp2f(-1.4426950408889634f * (acc[ai][1][m][n][i] + bv[1][n][i])), 1e18f);
                            const float R = __builtin_amdgcn_rcpf(d0 * d1);
                            rr[4 * n + i] = d1 * (d1 * R); gg[4 * n + i] = d0 * R; }
                    u32x4 w; w.x = cvt_pk_bf16(rr[0], rr[1]); w.y = cvt_pk_bf16(rr[2], rr[3]); w.z = cvt_pk_bf16(rr[4], rr[5]); w.w = cvt_pk_bf16(rr[6], rr[7]);
                    *(u32x4*)rowp = w;
                    w.x = cvt_pk_bf16(gg[0], gg[1]); w.y = cvt_pk_bf16(gg[2], gg[3]); w.z = cvt_pk_bf16(gg[4], gg[5]); w.w = cvt_pk_bf16(gg[6], gg[7]);
                    *(u32x4*)(rowp + 1024) = w; }
        } else if (pn >= 6 && pn < 10) {
            const float* g = (pn < 8) ? gq : gk; const float sc = (pn < 8) ? QC2 : 1.0f;
            f32x4 gv[2][2];
#pragma unroll
            for (int bj = 0; bj < 2; ++bj)
#pragma unroll
                for (int n = 0; n < 2; ++n) gv[bj][n] = *(const f32x4*)(g + 32 * bj + 8 * fq + 4 * n);
#pragma unroll
            for (int ai = 0; ai < 2; ++ai)
#pragma unroll
                for (int m = 0; m < 4; ++m) { const int row = row0 + ai * HALF + m * 16, pos = row & 4095;
                    float ss = 0.f;
#pragma unroll
                    for (int bj = 0; bj < 2; ++bj)
#pragma unroll
                        for (int n = 0; n < 2; ++n) { const f32x4 x = acc[ai][bj][m][n]; ss += (x[0] * x[0] + x[1] * x[1]) + (x[2] * x[2] + x[3] * x[3]); }
                    ss += __shfl_xor(ss, 16); ss += __shfl_xor(ss, 32);
                    const float rstd = __builtin_amdgcn_rsqf(ss * (1.0f / 64.0f) + 1e-6f);
                    f32x4 v[2][2];
#pragma unroll
                    for (int bj = 0; bj < 2; ++bj)
#pragma unroll
                        for (int n = 0; n < 2; ++n) v[bj][n] = acc[ai][bj][m][n] * rstd * gv[bj][n];
#pragma unroll
                    for (int n = 0; n < 2; ++n) { const f32x4 cs0 = *(const f32x4*)(rope + (size_t)pos * 16 + 8 * n), cs1 = *(const f32x4*)(rope + (size_t)pos * 16 + 8 * n + 4);
                        const float c[4] = {cs0[0], cs0[2], cs1[0], cs1[2]}, s[4] = {cs0[1], cs0[3], cs1[1], cs1[3]};
#pragma unroll
                        for (int i = 0; i < 4; ++i) { const float own = v[0][n][i], oth = __shfl_xor(own, 16);
                            const float r0 = own * c[i] - oth * s[i], r1 = own * c[i] + oth * s[i];
                            v[0][n][i] = (fq == 0) ? r0 : ((fq == 1) ? r1 : own); } }
                    bf16_t* rowp = proj + (size_t)row * PROJ_PITCH + lcol;
#pragma unroll
                    for (int bj = 0; bj < 2; ++bj) { const f32x4 v0 = v[bj][0] * sc, v1 = v[bj][1] * sc;
                        u32x4 w; w.x = cvt_pk_bf16(v0[0], v0[1]); w.y = cvt_pk_bf16(v0[2], v0[3]); w.z = cvt_pk_bf16(v1[0], v1[1]); w.w = cvt_pk_bf16(v1[2], v1[3]);
                        *(u32x4*)(rowp + 32 * bj) = w; } }
        } else {
            const float sc = (pn < 2) ? QC2 : 1.0f;
#pragma unroll
            for (int ai = 0; ai < 2; ++ai)
#pragma unroll
                for (int m = 0; m < 4; ++m) { bf16_t* rowp = proj + (size_t)(row0 + ai * HALF + m * 16) * PROJ_PITCH + lcol;
#pragma unroll
                    for (int bj = 0; bj < 2; ++bj) { const f32x4 v0 = acc[ai][bj][m][0] * sc, v1 = acc[ai][bj][m][1] * sc;
                        u32x4 w; w.x = cvt_pk_bf16(v0[0], v0[1]); w.y = cvt_pk_bf16(v0[2], v0[3]); w.z = cvt_pk_bf16(v1[0], v1[1]); w.w = cvt_pk_bf16(v1[2], v1[3]);
                        *(u32x4*)(rowp + 32 * bj) = w; } }
        }
    }
};

struct EpiMerge {
    static constexpr bool PERM = true, AFTER_DRAIN = false, MIDHOOK = true;
    bf16_t* merged; const bf16_t* gates;
    __device__ __forceinline__ void mid(f32x4 (&acc)[2][2][4][2], const Unit& u, int wr, int wc, int fr, int fq) const {
        int fr_l = fr; asm volatile("" : "+v"(fr_l));
        const int row0 = u.pm * BM + wr * 64 + fr_l, col0 = u.pn * BM + wc * 32 + 8 * fq;
#pragma unroll
        for (int ai = 0; ai < 2; ++ai) {
#pragma unroll
            for (int m = 0; m < 4; ++m) { const bf16_t* gp = gates + (size_t)(row0 + ai * HALF + m * 16) * GATE_PITCH + col0;
#pragma unroll
                for (int bj = 0; bj < 2; ++bj) { const u32x4 a = *(const u32x4*)(gp + bj * HALF);
                    acc[ai][bj][m][0][0] *= bf_lo(a.x); acc[ai][bj][m][0][1] *= bf_hi(a.x); acc[ai][bj][m][0][2] *= bf_lo(a.y); acc[ai][bj][m][0][3] *= bf_hi(a.y);
                    acc[ai][bj][m][1][0] *= bf_lo(a.z); acc[ai][bj][m][1][1] *= bf_hi(a.z); acc[ai][bj][m][1][2] *= bf_lo(a.w); acc[ai][bj][m][1][3] *= bf_hi(a.w); } }
            asm volatile("" ::: "memory"); }
    }
    __device__ __forceinline__ void operator()(const f32x4 (&acc)[2][2][4][2], const Unit& u, int wr, int wc, int fr, int fq) const {
        const int row0 = u.pm * BM + wr * 64 + fr, col0 = u.pn * BM + wc * 32 + 8 * fq;
#pragma unroll
        for (int ai = 0; ai < 2; ++ai)
#pragma unroll
            for (int m = 0; m < 4; ++m) { const size_t row = (size_t)(row0 + ai * HALF + m * 16);
#pragma unroll
                for (int bj = 0; bj < 2; ++bj) { const int col = col0 + bj * HALF; const u32x4 b = *(const u32x4*)(gates + row * GATE_PITCH + 1024 + col);
                    const f32x4 v0 = acc[ai][bj][m][0], v1 = acc[ai][bj][m][1];
                    u32x4 w; w.x = cvt_pk_bf16(v0[0] * bf_lo(b.x), v0[1] * bf_hi(b.x)); w.y = cvt_pk_bf16(v0[2] * bf_lo(b.y), v0[3] * bf_hi(b.y));
                    w.z = cvt_pk_bf16(v1[0] * bf_lo(b.z), v1[1] * bf_hi(b.z)); w.w = cvt_pk_bf16(v1[2] * bf_lo(b.w), v1[3] * bf_hi(b.w));
                    *(u32x4*)(merged + row * 1024 + col) = w; } }
    }
};

struct EpiWout {
    static constexpr bool PERM = true, AFTER_DRAIN = false, MIDHOOK = false;
    const float* x; bf16_t* x1b; float* ssq;
    __device__ __forceinline__ void operator()(const f32x4 (&acc)[2][2][4][2], const Unit& u, int wr, int wc, int fr, int fq) const {
        const int row0 = u.pm * BM + wr * 64 + fr, col0 = u.pn * BM + wc * 32 + 8 * fq;
#pragma unroll
        for (int ai = 0; ai < 2; ++ai)
#pragma unroll
            for (int m = 0; m < 4; ++m) { const size_t row = (size_t)(row0 + ai * HALF + m * 16); float ss = 0.f;
#pragma unroll
                for (int bj = 0; bj < 2; ++bj) { const size_t off = row * 1024 + col0 + bj * HALF;
                    const f32x4 v0 = *(const f32x4*)(x + off) + acc[ai][bj][m][0], v1 = *(const f32x4*)(x + off + 4) + acc[ai][bj][m][1];
                    ss += (v0[0] * v0[0] + v0[1] * v0[1]) + (v0[2] * v0[2] + v0[3] * v0[3]) + (v1[0] * v1[0] + v1[1] * v1[1]) + (v1[2] * v1[2] + v1[3] * v1[3]);
                    u32x4 w; w.x = cvt_pk_bf16(v0[0], v0[1]); w.y = cvt_pk_bf16(v0[2], v0[3]); w.z = cvt_pk_bf16(v1[0], v1[1]); w.w = cvt_pk_bf16(v1[2], v1[3]);
                    *(u32x4*)(x1b + off) = w; }
                ss += __shfl_xor(ss, 16); ss += __shfl_xor(ss, 32);
                if (fq == 0) ssq[row * 16 + u.pn * 4 + wc] = ss; }
    }
};
struct EpiFfnUp {
    static constexpr bool PERM = true, AFTER_DRAIN = false, MIDHOOK = false;
    bf16_t* ff; const float* ssq;
    __device__ __forceinline__ void operator()(const f32x4 (&acc)[2][2][4][2], const Unit& u, int wr, int wc, int fr, int fq) const {
        const int row0 = u.pm * BM + wr * 64 + fr, col0 = u.pn * 128 + wc * 32 + 8 * fq;
#pragma unroll
        for (int ai = 0; ai < 2; ++ai)
#pragma unroll
            for (int m = 0; m < 4; ++m) { const size_t row = (size_t)(row0 + ai * HALF + m * 16);
                const f32x4 s0 = *(const f32x4*)(ssq + row * 16), s1 = *(const f32x4*)(ssq + row * 16 + 4), s2 = *(const f32x4*)(ssq + row * 16 + 8), s3 = *(const f32x4*)(ssq + row * 16 + 12);
                const f32x4 st = (s0 + s1) + (s2 + s3);
                const float rstd = __builtin_amdgcn_rsqf(((st[0] + st[1]) + (st[2] + st[3])) * (1.0f / 1024.0f) + 1e-6f);
                float o[8];
#pragma unroll
                for (int n = 0; n < 2; ++n)
#pragma unroll
                    for (int i = 0; i < 4; ++i) { const float g = acc[ai][0][m][n][i] * rstd, up = acc[ai][1][m][n][i] * rstd; o[4 * n + i] = g * sigmoidf_fast(g) * up; }
                u32x4 w; w.x = cvt_pk_bf16(o[0], o[1]); w.y = cvt_pk_bf16(o[2], o[3]); w.z = cvt_pk_bf16(o[4], o[5]); w.w = cvt_pk_bf16(o[6], o[7]);
                *(u32x4*)(ff + row * 2816 + col0) = w; }
    }
};
struct EpiDown {
    static constexpr bool PERM = true, AFTER_DRAIN = false, MIDHOOK = false;
    float* out; const bf16_t* x1b;
    __device__ __forceinline__ void operator()(const f32x4 (&acc)[2][2][4][2], const Unit& u, int wr, int wc, int fr, int fq) const {
        const int row0 = u.pm * BM + wr * 64 + fr, col0 = u.pn * BM + wc * 32 + 8 * fq;
#pragma unroll
        for (int ai = 0; ai < 2; ++ai)
#pragma unroll
            for (int m = 0; m < 4; ++m) { const size_t row = (size_t)(row0 + ai * HALF + m * 16);
#pragma unroll
                for (int bj = 0; bj < 2; ++bj) { const size_t off = row * 1024 + col0 + bj * HALF; const u32x4 w = *(const u32x4*)(x1b + off);
                    f32x4 v0 = acc[ai][bj][m][0], v1 = acc[ai][bj][m][1];
                    v0[0] += bf_lo(w.x); v0[1] += bf_hi(w.x); v0[2] += bf_lo(w.y); v0[3] += bf_hi(w.y); v1[0] += bf_lo(w.z); v1[1] += bf_hi(w.z); v1[2] += bf_lo(w.w); v1[3] += bf_hi(w.w);
                    *(f32x4*)(out + off) = v0; *(f32x4*)(out + off + 4) = v1; } }
    }
};

template <class Epi, class Sched, bool ALIGN_EPI = false, bool SP2 = false>
__device__ __forceinline__ void gemm_phase(PG8_LAS unsigned char* lds, const Gemm g, const Sched& S, const Epi& E) {
    int tid_l = threadIdx.x; asm volatile("" : "+v"(tid_l));
    const int tid = tid_l, wid = __builtin_amdgcn_readfirstlane(tid >> 6), lane = tid & 63, wr = wid >> 2, wc = wid & 3, fr = lane & 15, fq = lane >> 4;
    const int K = g.K, nt = K / BK;
    unsigned voffA[2], voffB[2];
#pragma unroll
    for (int i = 0; i < 2; ++i) { int R, C; stage_rc(tid * 16 + i * 8192, R, C); const int Rb = Epi::PERM ? ((R & ~31) + perm32(R & 31)) : R;
        voffA[i] = (unsigned)(R * K + C) * 2u; voffB[i] = (unsigned)(Rb * K + C) * 2u; }
    const size_t kstep = (size_t)(BK * 2);
    const size_t hstep = (size_t)HALF * K * 2;
    const size_t tstep = 2 * hstep;
    const unsigned ldsw = (unsigned)wid * 1024u;
    const int aoff = lds_byte(wr * 64 + fr, fq * 8), boff = lds_byte(wc * 32 + fr, fq * 8);
#define PG8_SA(b, h) (((b) * 2 + (h)) * HTB)
#define PG8_SB(b, h) ((4 + (b) * 2 + (h)) * HTB)
#define PG8_STAGE(bufoff, gbase, voff) do { _Pragma("unroll") for (int _i = 0; _i < 2; ++_i) \
        __builtin_amdgcn_global_load_lds((const unsigned*)((const char*)(gbase) + (voff)[_i]), (PG8_LAS unsigned*)(lds + (bufoff) + ldsw + _i * 8192), 16, 0, 0); } while (0)
#define PG8_LDA(dst, b, h) do { _Pragma("unroll") for (int m = 0; m < 4; ++m) _Pragma("unroll") for (int k = 0; k < 2; ++k) dst[m][k] = *(const PG8_LAS bf16x8*)(lds + PG8_SA(b, h) + aoff + m * 2048 + k * 1024); } while (0)
#define PG8_LDB(dst, b, h) do { _Pragma("unroll") for (int n = 0; n < 2; ++n) _Pragma("unroll") for (int k = 0; k < 2; ++k) dst[n][k] = *(const PG8_LAS bf16x8*)(lds + PG8_SB(b, h) + boff + n * 2048 + k * 1024); } while (0)
#define PG8_MMA(ai, bj, At, Bt) do { __builtin_amdgcn_s_setprio(1); _Pragma("unroll") for (int m = 0; m < 4; ++m) _Pragma("unroll") for (int n = 0; n < 2; ++n) _Pragma("unroll") for (int k = 0; k < 2; ++k) \
        acc[ai][bj][m][n] = __builtin_amdgcn_mfma_f32_16x16x32_bf16(Bt[n][k], At[m][k], acc[ai][bj][m][n], 0, 0, 0); __builtin_amdgcn_s_setprio(0); } while (0)
#define PG8_WAIT_V(n) asm volatile("s_waitcnt vmcnt(" #n ")" ::: "memory")
#define PG8_WAIT_L(n) asm volatile("s_waitcnt lgkmcnt(" #n ")" ::: "memory")
#define PG8_BAR __builtin_amdgcn_s_barrier()
#define PG8_SCHED __builtin_amdgcn_sched_barrier(0)
    Unit cur, nxt; int ui = 0;
    if (!S.next(0, cur)) return;
    f32x4 acc[2][2][4][2];
#pragma unroll
    for (int a = 0; a < 2; ++a)
#pragma unroll
        for (int b = 0; b < 2; ++b)
#pragma unroll
            for (int m = 0; m < 4; ++m)
#pragma unroll
                for (int n = 0; n < 2; ++n) acc[a][b][m][n] = (f32x4){0.f, 0.f, 0.f, 0.f};
    bf16x8 At[4][2], B0[2][2], B1[2][2];
    const char* cA = (const char*)g.A + (size_t)cur.pm * tstep; const char* cB = (const char*)g.Bt + (size_t)cur.pn * tstep;
    S.a_ready(cur);
    if constexpr (SP2) {
        PG8_STAGE(PG8_SB(0, 0), cB, voffB); PG8_STAGE(PG8_SB(0, 1), cB + hstep, voffB); PG8_STAGE(PG8_SA(0, 0), cA, voffA); PG8_STAGE(PG8_SA(0, 1), cA + hstep, voffA);
        if (wr == 1) PG8_BAR;
        PG8_WAIT_V(2); PG8_BAR;
        PG8_STAGE(PG8_SB(1, 0), cB + kstep, voffB); PG8_STAGE(PG8_SA(1, 0), cA + kstep, voffA); PG8_STAGE(PG8_SB(1, 1), cB + hstep + kstep, voffB);
        PG8_WAIT_V(6); PG8_BAR;
    } else {
        PG8_STAGE(PG8_SB(0, 0), cB, voffB); PG8_STAGE(PG8_SA(0, 0), cA, voffA); PG8_STAGE(PG8_SB(0, 1), cB + hstep, voffB); PG8_STAGE(PG8_SA(0, 1), cA + hstep, voffA);
        if (wr == 1) PG8_BAR;
        PG8_WAIT_V(4); PG8_BAR;
        PG8_STAGE(PG8_SB(1, 0), cB + kstep, voffB); PG8_STAGE(PG8_SA(1, 0), cA + kstep, voffA); PG8_STAGE(PG8_SB(1, 1), cB + hstep + kstep, voffB);
        PG8_WAIT_V(6); PG8_BAR;
    }
    for (;;) {
        const bool has_next = S.next(ui + 1, nxt);
        const char* nA = has_next ? (const char*)g.A + (size_t)nxt.pm * tstep : cA; const char* nB = has_next ? (const char*)g.Bt + (size_t)nxt.pn * tstep : cB;
        for (int t = 0; t < nt; t += 2) {
            if constexpr (Epi::MIDHOOK) { if (t == (nt >> 1)) E.mid(acc, cur, wr, wc, fr, fq); }
            const bool last = (t == nt - 2);
            const char* a1 = cA + (size_t)(t + 1) * kstep;
            const char* a2 = last ? nA : cA + (size_t)(t + 2) * kstep; const char* b2 = last ? nB : cB + (size_t)(t + 2) * kstep;
            const char* a3 = a2 + kstep; const char* b3 = b2 + kstep;
            if (last && has_next) S.a_ready(nxt);
            if constexpr (SP2) {
            PG8_LDB(B0, 0, 0); PG8_LDB(B1, 0, 1); PG8_SCHED; PG8_LDA(At, 0, 0); PG8_STAGE(PG8_SA(1, 1), a1 + hstep, voffA);
            PG8_WAIT_V(8); PG8_WAIT_L(0); PG8_BAR; PG8_MMA(0, 0, At, B0); PG8_MMA(0, 1, At, B1); PG8_BAR; PG8_SCHED;
            PG8_LDA(At, 0, 1); PG8_STAGE(PG8_SB(0, 0), b2, voffB); PG8_STAGE(PG8_SB(0, 1), b2 + hstep, voffB); PG8_STAGE(PG8_SA(0, 0), a2, voffA);
            PG8_WAIT_V(8); PG8_WAIT_L(0); PG8_BAR; PG8_MMA(1, 0, At, B0); PG8_MMA(1, 1, At, B1); PG8_BAR; PG8_SCHED;
            PG8_LDB(B0, 1, 0); PG8_LDB(B1, 1, 1); PG8_SCHED; PG8_LDA(At, 1, 0); PG8_STAGE(PG8_SA(0, 1), a2 + hstep, voffA);
            PG8_WAIT_V(8); PG8_WAIT_L(0); PG8_BAR; PG8_MMA(0, 0, At, B0); PG8_MMA(0, 1, At, B1); PG8_BAR; PG8_SCHED;
            PG8_LDA(At, 1, 1); PG8_STAGE(PG8_SB(1, 0), b3, voffB); PG8_STAGE(PG8_SB(1, 1), b3 + hstep, voffB); PG8_STAGE(PG8_SA(1, 0), a3, voffA);
            PG8_WAIT_V(8); PG8_WAIT_L(0); PG8_BAR; PG8_MMA(1, 0, At, B0); PG8_MMA(1, 1, At, B1); PG8_BAR; PG8_SCHED;
            } else {
            PG8_LDB(B0, 0, 0); PG8_SCHED; PG8_LDA(At, 0, 0); PG8_STAGE(PG8_SA(1, 1), a1 + hstep, voffA);
            PG8_WAIT_L(8); PG8_BAR; PG8_WAIT_L(0); PG8_MMA(0, 0, At, B0); PG8_BAR; PG8_SCHED;
            PG8_LDB(B1, 0, 1); PG8_STAGE(PG8_SB(0, 0), b2, voffB);
            PG8_BAR; PG8_WAIT_L(0); PG8_MMA(0, 1, At, B1); PG8_BAR;
            PG8_LDA(At, 0, 1); PG8_STAGE(PG8_SA(0, 0), a2, voffA);
            PG8_BAR; PG8_WAIT_L(0); PG8_MMA(1, 0, At, B0); PG8_BAR; PG8_SCHED;
            PG8_STAGE(PG8_SB(0, 1), b2 + hstep, voffB);
            PG8_WAIT_V(6); PG8_BAR; PG8_MMA(1, 1, At, B1); PG8_BAR;
            PG8_LDB(B0, 1, 0); PG8_SCHED; PG8_LDA(At, 1, 0); PG8_STAGE(PG8_SA(0, 1), a2 + hstep, voffA);
            PG8_WAIT_L(8); PG8_BAR; PG8_WAIT_L(0); PG8_MMA(0, 0, At, B0); PG8_BAR; PG8_SCHED;
            PG8_LDB(B1, 1, 1); PG8_STAGE(PG8_SB(1, 0), b3, voffB);
            PG8_BAR; PG8_WAIT_L(0); PG8_MMA(0, 1, At, B1); PG8_BAR;
            PG8_LDA(At, 1, 1); PG8_STAGE(PG8_SA(1, 0), a3, voffA);
            PG8_BAR; PG8_WAIT_L(0); PG8_MMA(1, 0, At, B0); PG8_BAR; PG8_SCHED;
            PG8_STAGE(PG8_SB(1, 1), b3 + hstep, voffB);
            PG8_WAIT_V(6); PG8_BAR; PG8_MMA(1, 1, At, B1); PG8_BAR;
            }
        }
        if constexpr (ALIGN_EPI) { if (wr == 0) PG8_BAR; }
        if constexpr (!Epi::AFTER_DRAIN) { E(acc, cur, wr, wc, fr, fq); S.done(cur); }
        if (!has_next) break;
#pragma unroll
        for (int a = 0; a < 2; ++a)
#pragma unroll
            for (int b = 0; b < 2; ++b)
#pragma unroll
                for (int m = 0; m < 4; ++m)
#pragma unroll
                    for (int n = 0; n < 2; ++n) acc[a][b][m][n] = (f32x4){0.f, 0.f, 0.f, 0.f};
        cur = nxt; cA = nA; cB = nB; ++ui;
        if constexpr (ALIGN_EPI) { if (wr == 1) PG8_BAR; }
    }
    PG8_WAIT_V(0);
    if constexpr (!ALIGN_EPI) { if (wr == 0) PG8_BAR; }
    PG8_BAR;
    if constexpr (Epi::AFTER_DRAIN) { E.fused(acc, cur, wr, wc, fr, fq, lds, wid, lane); S.done(cur); }
#undef PG8_SA
#undef PG8_SB
#undef PG8_STAGE
#undef PG8_LDA
#undef PG8_LDB
#undef PG8_MMA
#undef PG8_WAIT_V
#undef PG8_WAIT_L
#undef PG8_BAR
#undef PG8_SCHED
}
}

namespace att {
#define LAS __attribute__((address_space(3)))
typedef unsigned short bf16;
typedef short bf16x8 __attribute__((ext_vector_type(8)));
typedef short s16x4 __attribute__((ext_vector_type(4)));
typedef float f32x16 __attribute__((ext_vector_type(16)));
typedef unsigned u32x4 __attribute__((ext_vector_type(4)));
constexpr int SEQ = 4096, PITCH = 3072;
__device__ __forceinline__ int crow(int r, int hi) { return (r & 3) + 8 * (r >> 2) + 4 * hi; }
#define SBAR() __builtin_amdgcn_sched_barrier(0)
__device__ __forceinline__ void glds16(const void* gsrc, unsigned lds_dst) { unsigned keep;
  asm volatile("s_mov_b32 %0, m0\n\ts_mov_b32 m0, %2\n\ts_nop 0\n\tglobal_load_lds_dwordx4 %1, off\n\ts_mov_b32 m0, %0" : "=&s"(keep) : "v"(gsrc), "s"(lds_dst) : "memory"); }
typedef float f32x2_t __attribute__((ext_vector_type(2))); typedef __bf16 bf16x2_t __attribute__((ext_vector_type(2)));
__device__ __forceinline__ unsigned cvtpk_s(float lo, float hi) { f32x2_t v = {lo, hi}; bf16x2_t b = __builtin_convertvector(v, bf16x2_t); return __builtin_bit_cast(unsigned, b); }
#define WAIT_BAR0() asm volatile("s_waitcnt vmcnt(0) lgkmcnt(0)\n\ts_barrier" ::: "memory")
__device__ __forceinline__ long kdma_off(int w, int lane, int pitch) { const int key = 8 * w + (lane >> 3), ch = (lane & 7) ^ ((key >> 1) & 7); return (long)key * pitch + ch * 8; }
__device__ __forceinline__ void qkt(f32x16& p0, f32x16& p1, const LAS char* Kslot, const bf16x8* qr, const f32x16& cinit, int r32, int hi) {
  const LAS char* kb = Kslot + r32 * 128; const int sw = (r32 >> 1) & 7;
#pragma unroll
  for (int d0 = 0; d0 < 4; ++d0) { const int co = ((2 * d0 + hi) ^ sw) << 4;
    const bf16x8 b0 = *(const LAS bf16x8*)(kb + co);
    const bf16x8 b1 = *(const LAS bf16x8*)(kb + co + 4096);
    if (d0 == 0) { p0 = __builtin_amdgcn_mfma_f32_32x32x16_bf16(b0, qr[0], cinit, 0, 0, 0); p1 = __builtin_amdgcn_mfma_f32_32x32x16_bf16(b1, qr[0], cinit, 0, 0, 0); }
    else { p0 = __builtin_amdgcn_mfma_f32_32x32x16_bf16(b0, qr[d0], p0, 0, 0, 0); p1 = __builtin_amdgcn_mfma_f32_32x32x16_bf16(b1, qr[d0], p1, 0, 0, 0); } }
}
__device__ __forceinline__ void pv(f32x16& oA, f32x16& oB, int vb, bf16x8 pa0, bf16x8 pa1, bf16x8 pa2, bf16x8 pa3) {
#pragma unroll
  for (int d0 = 0; d0 < 2; ++d0) { s16x4 lo[4], hi[4];
#pragma unroll
    for (int ks = 0; ks < 4; ++ks) {
      asm volatile("ds_read_b64_tr_b16 %0,%1 offset:%c2" : "=&v"(lo[ks]) : "v"(vb), "i"(d0 * 4096 + ks * 1024) : "memory");
      asm volatile("ds_read_b64_tr_b16 %0,%1 offset:%c2" : "=&v"(hi[ks]) : "v"(vb), "i"(d0 * 4096 + ks * 1024 + 512) : "memory"); }
    asm volatile("s_waitcnt lgkmcnt(0)" ::: "memory"); SBAR();
#define PK(k) (bf16x8){lo[k][0], lo[k][1], lo[k][2], lo[k][3], hi[k][0], hi[k][1], hi[k][2], hi[k][3]}
    f32x16 o = d0 ? oB : oA;
    o = __builtin_amdgcn_mfma_f32_32x32x16_bf16(pa0, PK(0), o, 0, 0, 0);
    o = __builtin_amdgcn_mfma_f32_32x32x16_bf16(pa1, PK(1), o, 0, 0, 0);
    o = __builtin_amdgcn_mfma_f32_32x32x16_bf16(pa2, PK(2), o, 0, 0, 0);
    o = __builtin_amdgcn_mfma_f32_32x32x16_bf16(pa3, PK(3), o, 0, 0, 0);
    if (d0) oB = o; else oA = o;
#undef PK
  }
}
typedef short v4i16_t __attribute__((ext_vector_type(4)));
__device__ __forceinline__ s16x4 vtr(const LAS char* p) { return __builtin_bit_cast(s16x4, __builtin_amdgcn_ds_read_tr16_b64_v4i16((LAS v4i16_t*)p)); }
__device__ __forceinline__ void pv2(f32x16& oA, f32x16& oB, const LAS char* vp, bf16x8 pa0, bf16x8 pa1, bf16x8 pa2, bf16x8 pa3) {
  s16x4 lo[8], hi[8];
#pragma unroll
  for (int i = 0; i < 8; ++i) { lo[i] = vtr(vp + (i >> 2) * 4096 + (i & 3) * 1024); hi[i] = vtr(vp + (i >> 2) * 4096 + (i & 3) * 1024 + 512); }
#define PK(k) (bf16x8){lo[k][0], lo[k][1], lo[k][2], lo[k][3], hi[k][0], hi[k][1], hi[k][2], hi[k][3]}
  oA = __builtin_amdgcn_mfma_f32_32x32x16_bf16(pa0, PK(0), oA, 0, 0, 0); oB = __builtin_amdgcn_mfma_f32_32x32x16_bf16(pa0, PK(4), oB, 0, 0, 0);
  oA = __builtin_amdgcn_mfma_f32_32x32x16_bf16(pa1, PK(1), oA, 0, 0, 0); oB = __builtin_amdgcn_mfma_f32_32x32x16_bf16(pa1, PK(5), oB, 0, 0, 0);
  oA = __builtin_amdgcn_mfma_f32_32x32x16_bf16(pa2, PK(2), oA, 0, 0, 0); oB = __builtin_amdgcn_mfma_f32_32x32x16_bf16(pa2, PK(6), oB, 0, 0, 0);
  oA = __builtin_amdgcn_mfma_f32_32x32x16_bf16(pa3, PK(3), oA, 0, 0, 0); oB = __builtin_amdgcn_mfma_f32_32x32x16_bf16(pa3, PK(7), oB, 0, 0, 0);
#undef PK
}
#define PACK_P(P0, P1) \
  const u32x4 pw0 = (u32x4){cvtpk_s(P0[0], P0[1]), cvtpk_s(P0[2], P0[3]), cvtpk_s(P0[4], P0[5]), cvtpk_s(P0[6], P0[7])}; \
  const u32x4 pw1 = (u32x4){cvtpk_s(P0[8], P0[9]), cvtpk_s(P0[10], P0[11]), cvtpk_s(P0[12], P0[13]), cvtpk_s(P0[14], P0[15])}; \
  const u32x4 pw2 = (u32x4){cvtpk_s(P1[0], P1[1]), cvtpk_s(P1[2], P1[3]), cvtpk_s(P1[4], P1[5]), cvtpk_s(P1[6], P1[7])}; \
  const u32x4 pw3 = (u32x4){cvtpk_s(P1[8], P1[9]), cvtpk_s(P1[10], P1[11]), cvtpk_s(P1[12], P1[13]), cvtpk_s(P1[14], P1[15])};
#define PAF(k) __builtin_bit_cast(bf16x8, pw##k)
__device__ __forceinline__ unsigned short f2bf1(float v) { return (unsigned short)(cvtpk_s(v, 0.f) & 0xffffu); }

constexpr float SB_STOP = -40.0f;
constexpr int SB_STAGE = 65536, SB_LDS_V = 32768, SB_LDS_FLAG = 131072;
__device__ __forceinline__ void sb_unit(int b, int hg, int c, const bf16* __restrict__ P, bf16* __restrict__ OA, char* shm) {
  int tid_l = threadIdx.x; asm volatile("" : "+v"(tid_l)); const int tid = tid_l, lane = tid & 63, r32 = lane & 31, hi = lane >> 5; const int wid = __builtin_amdgcn_readfirstlane(tid >> 6);
  const int hw = wid >> 1, h = 4 * hg + hw, half = wid & 1;
  const long rowbase = (long)b * SEQ; const int q0 = c * 64;
  const bf16* Qw = P + (rowbase + q0 + half * 32) * PITCH + h * 64;
  const bf16* Kg = P + rowbase * PITCH + 512 + hg * 256; const bf16* Vg = P + rowbase * PITCH + 1024 + hg * 256;
  const unsigned lds0 = (unsigned)(uintptr_t)shm;
  const LAS char* shm3 = (const LAS char*)shm;
  volatile LAS unsigned* flags = (volatile LAS unsigned*)(shm3 + SB_LDS_FLAG);
  const bf16* ksrc = Kg + kdma_off(wid, lane, PITCH);
  const bf16* vsrc = Vg + (long)(16 * (wid & 3) + (lane >> 2)) * PITCH + (wid >> 2) * 32 + (lane & 3) * 8;
  const unsigned pdst = lds0 + wid * 1024;
  const LAS char* kp0 = shm3 + hw * 8192;
  const LAS char* vp0 = shm3 + SB_LDS_V + hw * 8192 + ((lane >> 4) & 1) * 32 + (lane & 3) * 8 + (4 * hi + ((lane & 15) >> 2)) * 64;
#define SB_DMA(t, st) do { const long go_ = (long)(t) * 64 * PITCH; const unsigned d_ = (unsigned)__builtin_amdgcn_readfirstlane(pdst + (st) * SB_STAGE); \
    _Pragma("unroll") for (int hh = 0; hh < 4; ++hh) { glds16(ksrc + go_ + hh * 64, d_ + hh * 8192); glds16(vsrc + go_ + hh * 64, d_ + SB_LDS_V + hh * 8192); } } while (0)
  SB_DMA(c, 0);
  bf16x8 qr[4];
#pragma unroll
  for (int d0 = 0; d0 < 4; ++d0) qr[d0] = *(const bf16x8*)(Qw + (long)r32 * PITCH + d0 * 16 + hi * 8);
  f32x16 oA = f32x16{}, oB = f32x16{}; const f32x16 zero = f32x16{};
  float carry = 0.f;
  const int qrow = half * 32 + r32;
  int cur = 0;
  for (int t = c; t >= 0; --t) {
    WAIT_BAR0();
    if (t != c) { const unsigned f = flags[(cur ^ 1) * 8 + (lane & 7)]; if (__all(f != 0u)) break; }
    if (t > 0) SB_DMA(t - 1, cur ^ 1);
    {
      f32x16 p0, p1, l0, l1;
      qkt(p0, p1, kp0 + cur * SB_STAGE, qr, zero, r32, hi);
      const bool diag = (t == c); const int kvb = 4 * hi;
#pragma unroll
      for (int r = 0; r < 16; ++r) {
        { const float x = p0[r], e = __builtin_amdgcn_exp2f(-__builtin_fabsf(x)), sp = __builtin_fmaxf(x, 0.f) + __builtin_amdgcn_logf(1.0f + e);
          float l = -sp, zl = x - sp; if (diag) { const bool ok = (kvb + (r & 3) + 8 * (r >> 2)) < qrow; l = ok ? l : 0.f; zl = ok ? zl : -INFINITY; } l0[r] = l; p0[r] = zl; }
        { const float x = p1[r], e = __builtin_amdgcn_exp2f(-__builtin_fabsf(x)), sp = __builtin_fmaxf(x, 0.f) + __builtin_amdgcn_logf(1.0f + e);
          float l = -sp, zl = x - sp; if (diag) { const bool ok = (kvb + 32 + (r & 3) + 8 * (r >> 2)) < qrow; l = ok ? l : 0.f; zl = ok ? zl : -INFINITY; } l1[r] = l; p1[r] = zl; }
      }
      float gs[8], ps[8];
#pragma unroll
      for (int g = 0; g < 4; ++g) { gs[g] = (l0[4 * g] + l0[4 * g + 1]) + (l0[4 * g + 2] + l0[4 * g + 3]); gs[4 + g] = (l1[4 * g] + l1[4 * g + 1]) + (l1[4 * g + 2] + l1[4 * g + 3]); }
#pragma unroll
      for (int g = 0; g < 8; ++g) ps[g] = __shfl_xor(gs[g], 32);
      float R = carry;
#pragma unroll
      for (int gi = 7; gi >= 0; --gi) {
        float E = R + (hi == 0 ? ps[gi] : 0.f);
        R += gs[gi] + ps[gi];
        const int g = gi & 3;
        if (gi >= 4) { p1[4 * g + 3] = __builtin_amdgcn_exp2f(p1[4 * g + 3] + E); E += l1[4 * g + 3]; p1[4 * g + 2] = __builtin_amdgcn_exp2f(p1[4 * g + 2] + E); E += l1[4 * g + 2];
                       p1[4 * g + 1] = __builtin_amdgcn_exp2f(p1[4 * g + 1] + E); E += l1[4 * g + 1]; p1[4 * g] = __builtin_amdgcn_exp2f(p1[4 * g] + E); }
        else         { p0[4 * g + 3] = __builtin_amdgcn_exp2f(p0[4 * g + 3] + E); E += l0[4 * g + 3]; p0[4 * g + 2] = __builtin_amdgcn_exp2f(p0[4 * g + 2] + E); E += l0[4 * g + 2];
                       p0[4 * g + 1] = __builtin_amdgcn_exp2f(p0[4 * g + 1] + E); E += l0[4 * g + 1]; p0[4 * g] = __builtin_amdgcn_exp2f(p0[4 * g] + E); }
      }
      carry = R;
      PACK_P(p0, p1)
      pv2(oA, oB, vp0 + cur * SB_STAGE, PAF(0), PAF(1), PAF(2), PAF(3));
    }
    if (lane == 0) flags[cur * 8 + wid] = __any(carry > SB_STOP) ? 0u : 1u;
    cur ^= 1;
  }
#undef SB_DMA
  WAIT_BAR0();
  bf16* Ow = OA + (rowbase + q0 + half * 32) * 1024 + h * 64;
#pragma unroll
  for (int r = 0; r < 16; ++r) { const int orow = crow(r, hi); Ow[(long)orow * 1024 + r32] = f2bf1(oA[r]); Ow[(long)orow * 1024 + 32 + r32] = f2bf1(oB[r]); }
}

constexpr int DA_VBASE = 32768, DA_WS = 81920;
__device__ __forceinline__ void da_unit(int b, int h, int qb, const bf16* __restrict__ P, bf16* __restrict__ OB, char* shm, float lam, const float* __restrict__ gsub) {
  int tid_l = threadIdx.x; asm volatile("" : "+v"(tid_l)); const int tid = tid_l, lane = tid & 63, r32 = lane & 31, hi = lane >> 5; const int wid = __builtin_amdgcn_readfirstlane(tid >> 6);
  const int comp = wid >> 2, wq = wid & 3;
  const long rowbase = (long)b * SEQ; const int q0 = qb * 128;
  const bf16* Qw = P + (rowbase + q0 + wq * 32) * PITCH + 1536 + h * 128 + comp * 64;
  const bf16* Kh = P + rowbase * PITCH + 2048 + h * 128; const bf16* Vh = P + rowbase * PITCH + 2560 + h * 128;
  const unsigned lds0 = (unsigned)(uintptr_t)shm;
  const LAS char* shm3 = (const LAS char*)shm;
  LAS float* wsf = (LAS float*)(shm3 + DA_WS) + wid * 64;
  const bf16* ksrc = Kh + kdma_off(wid, lane, PITCH);
  const bf16* vsrc = Vh + (long)(16 * (wid & 3) + (lane >> 2)) * PITCH + (wid >> 2) * 32 + (lane & 3) * 8;
  const unsigned pdst = lds0 + wid * 1024;
  const LAS char* vp0 = shm3 + ((lane >> 4) & 1) * 32 + (lane & 3) * 8 + (4 * hi + ((lane & 15) >> 2)) * 64;
  const int NT = 2 * qb + 2, my_last = 2 * qb + (wq >> 1);
#define DA_DMA_K(t, sl) do { const long go_ = (long)(t) * 64 * PITCH; const unsigned d_ = (unsigned)__builtin_amdgcn_readfirstlane(pdst + (sl) * 16384); glds16(ksrc + go_, d_); glds16(ksrc + go_ + 64, d_ + 8192); } while (0)
#define DA_DMA_V(t, sl) do { const long go_ = (long)(t) * 64 * PITCH; const unsigned d_ = (unsigned)__builtin_amdgcn_readfirstlane(pdst + DA_VBASE + (sl) * 16384); glds16(vsrc + go_, d_); glds16(vsrc + go_ + 64, d_ + 8192); } while (0)
  DA_DMA_K(0, 0); DA_DMA_V(0, 0); DA_DMA_K(1, 1);
  bf16x8 qr[4];
#pragma unroll
  for (int d0 = 0; d0 < 4; ++d0) qr[d0] = *(const bf16x8*)(Qw + (long)r32 * PITCH + d0 * 16 + hi * 8);
  f32x16 o0 = f32x16{}, o1 = f32x16{}, o2 = f32x16{}, o3 = f32x16{}; const f32x16 zero = f32x16{};
  float lsum = 0.f;
  WAIT_BAR0();
  int kco[4];
#pragma unroll
  for (int d0 = 0; d0 < 4; ++d0) kco[d0] = ((2 * d0 + hi) ^ ((r32 >> 1) & 7)) << 4;
  f32x16 sc0, sc1;
  qkt(sc0, sc1, shm3 + comp * 8192, qr, zero, r32, hi);
  u32x4 pw0 = {0u, 0u, 0u, 0u}, pw1 = pw0, pw2 = pw0, pw3 = pw0;
#define DA_PK(L, H, k) (bf16x8){L[k][0], L[k][1], L[k][2], L[k][3], H[k][0], H[k][1], H[k][2], H[k][3]}
#define DA_PVMM(VP) do { const LAS char* vq_ = (VP); s16x4 lo_[8], hi_[8], lo2_[8], hi2_[8]; \
      _Pragma("unroll") for (int i = 0; i < 8; ++i) { lo_[i] = vtr(vq_ + (i >> 2) * 4096 + (i & 3) * 1024); hi_[i] = vtr(vq_ + (i >> 2) * 4096 + (i & 3) * 1024 + 512); } \
      SBAR(); \
      _Pragma("unroll") for (int k = 0; k < 4; ++k) { const bf16x8 pa_ = (k == 0) ? PAF(0) : (k == 1) ? PAF(1) : (k == 2) ? PAF(2) : PAF(3); \
        o0 = __builtin_amdgcn_mfma_f32_32x32x16_bf16(pa_, DA_PK(lo_, hi_, k), o0, 0, 0, 0); o1 = __builtin_amdgcn_mfma_f32_32x32x16_bf16(pa_, DA_PK(lo_, hi_, k + 4), o1, 0, 0, 0); } \
      _Pragma("unroll") for (int i = 0; i < 8; ++i) { lo2_[i] = vtr(vq_ + 8192 + (i >> 2) * 4096 + (i & 3) * 1024); hi2_[i] = vtr(vq_ + 8192 + (i >> 2) * 4096 + (i & 3) * 1024 + 512); } \
      SBAR(); \
      _Pragma("unroll") for (int k = 0; k < 4; ++k) { const bf16x8 pa_ = (k == 0) ? PAF(0) : (k == 1) ? PAF(1) : (k == 2) ? PAF(2) : PAF(3); \
        o2 = __builtin_amdgcn_mfma_f32_32x32x16_bf16(pa_, DA_PK(lo2_, hi2_, k), o2, 0, 0, 0); o3 = __builtin_amdgcn_mfma_f32_32x32x16_bf16(pa_, DA_PK(lo2_, hi2_, k + 4), o3, 0, 0, 0); } \
      SBAR(); } while (0)
#define DA_STEP(T, ACT, ACTN, PVP, VAR) do { \
    WAIT_BAR0(); \
    const int v0_ = vs0, v1_ = (vs0 == 2) ? 0 : vs0 + 1, vm_ = (v1_ == 2) ? 0 : v1_ + 1; vs0 = v1_; \
    if ((T) + 2 < NT) DA_DMA_K((T) + 2, (T) & 1); \
    if ((T) + 1 < NT) DA_DMA_V((T) + 1, v1_); \
    if (VAR == 1) { if (PVP) DA_PVMM(vp0 + DA_VBASE + vm_ * 16384); } \
    const LAS char* kb_ = shm3 + (((T) + 1) & 1) * 16384 + comp * 8192 + r32 * 128; \
    bf16x8 kf_[4]; f32x16 sn0_ = sc0, sn1_ = sc1; \
    if (ACTN) { _Pragma("unroll") for (int d0 = 0; d0 < 2; ++d0) { kf_[2 * d0] = *(const LAS bf16x8*)(kb_ + kco[d0]); kf_[2 * d0 + 1] = *(const LAS bf16x8*)(kb_ + kco[d0] + 4096); } } \
    SBAR(); \
    if (ACTN) { sn0_ = __builtin_amdgcn_mfma_f32_32x32x16_bf16(kf_[0], qr[0], zero, 0, 0, 0); sn1_ = __builtin_amdgcn_mfma_f32_32x32x16_bf16(kf_[1], qr[0], zero, 0, 0, 0); \
      sn0_ = __builtin_amdgcn_mfma_f32_32x32x16_bf16(kf_[2], qr[1], sn0_, 0, 0, 0); sn1_ = __builtin_amdgcn_mfma_f32_32x32x16_bf16(kf_[3], qr[1], sn1_, 0, 0, 0); \
      _Pragma("unroll") for (int d0 = 2; d0 < 4; ++d0) { kf_[2 * d0 - 4] = *(const LAS bf16x8*)(kb_ + kco[d0]); kf_[2 * d0 - 3] = *(const LAS bf16x8*)(kb_ + kco[d0] + 4096); } \
      sn0_ = __builtin_amdgcn_mfma_f32_32x32x16_bf16(kf_[0], qr[2], sn0_, 0, 0, 0); sn1_ = __builtin_amdgcn_mfma_f32_32x32x16_bf16(kf_[1], qr[2], sn1_, 0, 0, 0); \
      sn0_ = __builtin_amdgcn_mfma_f32_32x32x16_bf16(kf_[2], qr[3], sn0_, 0, 0, 0); sn1_ = __builtin_amdgcn_mfma_f32_32x32x16_bf16(kf_[3], qr[3], sn1_, 0, 0, 0); } \
    if (ACT) { \
      float e0_ = 0.f, e1_ = 0.f; \
      _Pragma("unroll") for (int r = 0; r < 16; ++r) { sc0[r] = __builtin_amdgcn_exp2f(sc0[r]); sc1[r] = __builtin_amdgcn_exp2f(sc1[r]); e0_ += sc0[r]; e1_ += sc1[r]; } \
      lsum += e0_ + e1_; \
      pw0 = (u32x4){cvtpk_s(sc0[0], sc0[1]), cvtpk_s(sc0[2], sc0[3]), cvtpk_s(sc0[4], sc0[5]), cvtpk_s(sc0[6], sc0[7])}; \
      pw1 = (u32x4){cvtpk_s(sc0[8], sc0[9]), cvtpk_s(sc0[10], sc0[11]), cvtpk_s(sc0[12], sc0[13]), cvtpk_s(sc0[14], sc0[15])}; \
      pw2 = (u32x4){cvtpk_s(sc1[0], sc1[1]), cvtpk_s(sc1[2], sc1[3]), cvtpk_s(sc1[4], sc1[5]), cvtpk_s(sc1[6], sc1[7])}; \
      pw3 = (u32x4){cvtpk_s(sc1[8], sc1[9]), cvtpk_s(sc1[10], sc1[11]), cvtpk_s(sc1[12], sc1[13]), cvtpk_s(sc1[14], sc1[15])}; \
      _Pragma("unroll") for (int i = 0; i < 8; ++i) { __builtin_amdgcn_sched_group_barrier(0x008, 1, 0); __builtin_amdgcn_sched_group_barrier(0x002, 10, 0); } \
    } \
    SBAR(); \
    if (VAR == 0) { if (ACT) DA_PVMM(vp0 + DA_VBASE + v0_ * 16384); } \
    sc0 = sn0_; sc1 = sn1_; \
  } while (0)
  int t = 0, vs0 = 0;
  if (comp == 0) {
#pragma unroll 1
    for (; t + 2 < NT; ++t) DA_STEP(t, true, true, false, 0);
#pragma unroll 1
    for (; t < NT; ++t) DA_STEP(t, (t <= my_last), (t + 1 <= my_last), false, 0);
  } else {
#pragma unroll 1
    for (; t + 2 < NT; ++t) DA_STEP(t, true, true, (t >= 1), 1);
#pragma unroll 1
    for (; t < NT; ++t) DA_STEP(t, (t <= my_last), (t + 1 <= my_last), (t >= 1 && t - 1 <= my_last), 1);
    if (NT - 1 <= my_last) DA_PVMM(vp0 + DA_VBASE + (((NT - 1) % 3) * 16384));
  }
#undef DA_STEP
#undef DA_PVMM
#undef DA_PK
#undef DA_DMA_K
#undef DA_DMA_V
  lsum += __shfl_xor(lsum, 32);
  if (hi == 0) wsf[r32] = lsum;
  WAIT_BAR0();
  float rl[16];
#pragma unroll
  for (int r = 0; r < 16; ++r) rl[r] = __builtin_amdgcn_rcpf(wsf[crow(r, hi)]) * (comp ? lam : 1.0f);
#pragma unroll
  for (int r = 0; r < 16; ++r) { o0[r] *= rl[r]; o1[r] *= rl[r]; o2[r] *= rl[r]; o3[r] *= rl[r]; }
  LAS float* X = (LAS float*)shm3;
  if (comp == 1) {
#pragma unroll
    for (int r = 0; r < 16; ++r) { LAS float* xr = X + (wq * 32 + crow(r, hi)) * 128 + r32; xr[0] = o0[r]; xr[32] = o1[r]; xr[64] = o2[r]; xr[96] = o3[r]; }
  }
  WAIT_BAR0();
  if (comp == 0) {
    const float g0 = gsub[r32] * 0.8f, g1 = gsub[32 + r32] * 0.8f, g2 = gsub[64 + r32] * 0.8f, g3 = gsub[96 + r32] * 0.8f;
    bf16* Ow = OB + (rowbase + q0 + wq * 32) * 1024 + 512 + h * 128;
#pragma unroll
    for (int r = 0; r < 16; ++r) { const LAS float* xr = X + (wq * 32 + crow(r, hi)) * 128 + r32;
      const float a0 = o0[r] - xr[0], a1 = o1[r] - xr[32], a2 = o2[r] - xr[64], a3 = o3[r] - xr[96];
      float ss = (a0 * a0 + a1 * a1) + (a2 * a2 + a3 * a3);
      ss += __shfl_xor(ss, 1); ss += __shfl_xor(ss, 2); ss += __shfl_xor(ss, 4); ss += __shfl_xor(ss, 8); ss += __shfl_xor(ss, 16);
      const float rstd = __builtin_amdgcn_rsqf(ss * (1.0f / 128.0f) + 1e-6f);
      bf16* op = Ow + (long)crow(r, hi) * 1024 + r32;
      op[0] = f2bf1(a0 * rstd * g0); op[32] = f2bf1(a1 * rstd * g1); op[64] = f2bf1(a2 * rstd * g2); op[96] = f2bf1(a3 * rstd * g3); }
  }
  WAIT_BAR0();
}
#undef SBAR
}

namespace cg = cooperative_groups;
constexpr int NWAVES = 8;
constexpr int BATCH = 4, SEQ = 4096, D = 1024, M = BATCH * SEQ, FF = 2816, NPG = 5120  , NGU = 2 * FF;
constexpr size_t MiB = 1u << 20;
constexpr size_t WS_SSQ = 1 * MiB, WS_ROPE = 2 * MiB, WS_W1 = 4 * MiB, WS_WAB = 14 * MiB, WS_WOUT = 16 * MiB, WS_WGU = 18 * MiB, WS_WD = 29 * MiB;
constexpr size_t WS_XN = 36 * MiB, WS_PROJ = 68 * MiB, WS_MERGED = 156 * MiB, WS_FF = 68 * MiB, WS_GATES = 192 * MiB, WS_END = 256 * MiB;
constexpr int LDS_BYTES = 147456;

typedef unsigned short bf16;
typedef unsigned v4u __attribute__((ext_vector_type(4)));
typedef float f32x4 __attribute__((ext_vector_type(4)));
#define LDS_WAIT() asm volatile("s_waitcnt lgkmcnt(0)" ::: "memory")
__device__ __forceinline__ unsigned pk2(float lo, float hi) { return pg8::cvt_pk_bf16(lo, hi); }
__device__ __forceinline__ float wave_sum(float v) {
#pragma unroll
    for (int o = 1; o < 64; o <<= 1) v += __shfl_xor(v, o);
    return v;
}
__device__ __forceinline__ float wave_max(float v) {
#pragma unroll
    for (int o = 1; o < 64; o <<= 1) v = __builtin_fmaxf(v, __shfl_xor(v, o));
    return v;
}
__device__ __forceinline__ void tr_item64(const float* __restrict__ W, int srcN, int colA, int colB, int k0, bf16* __restrict__ WT, int K, int dstrow0, const float* __restrict__ gk, LAS float* scr, int lane) {
    const int n4 = (lane & 15) * 4, kq = lane >> 4;
    const int scol = (n4 < 32 ? colA : colB) + (n4 & 31);
    f32x4 v[16];
#pragma unroll
    for (int i = 0; i < 16; ++i) v[i] = *(const f32x4*)(W + (size_t)(k0 + 4 * i + kq) * srcN + scol);
#pragma unroll
    for (int i = 0; i < 16; ++i) { f32x4 w = v[i]; if (gk) w = w * gk[k0 + 4 * i + kq]; *(LAS f32x4*)(scr + (4 * i + kq) * 68 + n4) = w; }
    LDS_WAIT(); asm volatile("" ::: "memory");
    const int c = lane & 7;
#pragma unroll
    for (int j = 0; j < 8; ++j) { const int n = (lane >> 3) + 8 * j; const LAS float* sp = scr + (8 * c) * 68 + n;
        v4u o; o.x = pk2(sp[0], sp[68]); o.y = pk2(sp[2 * 68], sp[3 * 68]); o.z = pk2(sp[4 * 68], sp[5 * 68]); o.w = pk2(sp[6 * 68], sp[7 * 68]);
        *(v4u*)(WT + (size_t)(dstrow0 + n) * K + k0 + 8 * c) = o; }
    LDS_WAIT(); asm volatile("" ::: "memory");
}

#define XB_TMO      128
#define XB_XCNT(j)  (256  + 64 * (j))
#define XB_XSUB(j)  (1280 + 64 * (j))
#define XB_XGEN(j)  (2304 + 64 * (j))
#define XB_TOP      3328
#define XB_TOPGEN   3392
#define XCD_BAR_WORDS 3456
#define XB_SPIN_CAP (1u << 18)

__device__ __forceinline__ unsigned xb_ld(unsigned* p)              { return __hip_atomic_load(p, __ATOMIC_RELAXED, __HIP_MEMORY_SCOPE_AGENT); }
__device__ __forceinline__ unsigned xb_add(unsigned* p, unsigned v) { return __hip_atomic_fetch_add(p, v, __ATOMIC_RELAXED, __HIP_MEMORY_SCOPE_AGENT); }
__device__ __forceinline__ unsigned xb_xcc_id() { return (unsigned)__builtin_amdgcn_s_getreg((3 << 11) | 20) & 0xFu; }
#define XB_SPIN(cond, bar) do { unsigned _sp = 0; while (cond) { __builtin_amdgcn_s_sleep(1); \
    if ((++_sp & 255u) == 0u) { if (xb_ld(&(bar)[XB_TMO])) break; if (_sp > XB_SPIN_CAP) { atomicAdd(&(bar)[XB_TMO], 1u); break; } } } } while (0)

struct XcdBarrier {
    unsigned* bar; unsigned x;
    volatile LAS unsigned* st;
};

__device__ __forceinline__ XcdBarrier xcd_barrier_post(unsigned* bar, volatile LAS unsigned* st) {
    XcdBarrier b; b.bar = bar; b.x = xb_xcc_id(); b.st = st;
    if (threadIdx.x == 0) (void)xb_add(&bar[XB_XCNT(b.x)], 1u);
    return b;
}
__device__ __forceinline__ void xcd_barrier_complete(unsigned* bar, unsigned x, unsigned& nloc, unsigned& nx) {
    const unsigned G = gridDim.x * gridDim.y * gridDim.z;
    unsigned sum, cnt, mine, sp = 0u;
    for (;;) {
        sum = 0u; cnt = 0u; mine = 0u;
#pragma unroll
        for (unsigned j = 0; j < 16; ++j) { const unsigned c = xb_ld(&bar[XB_XCNT(j)]); sum += c; cnt += (c > 0u) ? 1u : 0u; mine = (j == x) ? c : mine; }
        if (sum == G) break;
        __builtin_amdgcn_s_sleep(1);
        if ((++sp & 255u) == 0u) { if (xb_ld(&bar[XB_TMO])) break; if (sp > XB_SPIN_CAP) { atomicAdd(&bar[XB_TMO], 1u); break; } }
    }
    nloc = mine > 0u ? mine : 1u; nx = cnt > 0u ? cnt : 1u;
}

__device__ __forceinline__ void xcd_barrier(const XcdBarrier& b) {
    asm volatile("s_waitcnt vmcnt(0)" ::: "memory");
    __syncthreads();
    if (threadIdx.x == 0) {
        unsigned* bar = b.bar;
        __builtin_amdgcn_s_waitcnt(0);
        unsigned nloc = b.st[0], nx = b.st[1];
        if (nloc == 0u) { xcd_barrier_complete(bar, b.x, nloc, nx); b.st[0] = nloc; b.st[1] = nx; }
        const unsigned old = xb_add(&bar[XB_XSUB(b.x)], 1u);
        const unsigned gen = old / nloc;
        if (old + 1u == (gen + 1u) * nloc) {
            __builtin_amdgcn_fence(__ATOMIC_RELEASE, "agent");
            asm volatile("s_waitcnt vmcnt(0)" ::: "memory");
            const unsigned og = xb_add(&bar[XB_TOP], 1u);
            const unsigned tg = og / nx;
            if (og + 1u == (tg + 1u) * nx) xb_add(&bar[XB_TOPGEN], 1u);
            else XB_SPIN(xb_ld(&bar[XB_TOPGEN]) == tg, bar);
            __builtin_amdgcn_fence(__ATOMIC_ACQUIRE, "agent");
            xb_add(&bar[XB_XGEN(b.x)], 1u);
            asm volatile("s_waitcnt vmcnt(0)" ::: "memory");
        } else {
            XB_SPIN(xb_ld(&bar[XB_XGEN(b.x)]) == gen, bar);
            __builtin_amdgcn_fence(__ATOMIC_ACQUIRE, "agent");
            asm volatile("s_waitcnt vmcnt(0)" ::: "memory");
        }
    }
    __syncthreads();
}

__device__ __forceinline__ void own_grid_barrier(unsigned* bar, unsigned target, bool wb = true) {
    asm volatile("s_waitcnt vmcnt(0) lgkmcnt(0)" ::: "memory");
    __syncthreads();
    if (threadIdx.x == 0) {
        if (wb) { __builtin_amdgcn_fence(__ATOMIC_RELEASE, "agent"); asm volatile("s_waitcnt vmcnt(0)" ::: "memory"); }
        (void)__hip_atomic_fetch_add(bar, 1u, __ATOMIC_RELAXED, __HIP_MEMORY_SCOPE_AGENT);
        unsigned spins = 0u;
        while (__hip_atomic_load(bar, __ATOMIC_RELAXED, __HIP_MEMORY_SCOPE_AGENT) < target) { __builtin_amdgcn_s_sleep(2); if (++spins > (1u << 24)) break; }
        __builtin_amdgcn_fence(__ATOMIC_ACQUIRE, "agent");
        asm volatile("s_waitcnt vmcnt(0)" ::: "memory");
    }
    __syncthreads();
}

struct Args { const float* in[19]; float* out; unsigned char* ws; };

__global__ void __launch_bounds__(NWAVES * 64, 2) mk_fwd(Args args) {
    extern __shared__ __attribute__((aligned(16))) unsigned char lds[];
    cg::grid_group grid = cg::this_grid();
    LAS unsigned char* ldsl = (LAS unsigned char*)lds;
#define PHASE_TID() int tid_l = threadIdx.x; asm volatile("" : "+v"(tid_l)); const int tid = tid_l, lane = tid & 63, wave = __builtin_amdgcn_readfirstlane(tid >> 6); (void)tid; (void)lane; (void)wave
    const int G = gridDim.x, bx = blockIdx.x, vcu = (G % 8 == 0) ? (bx % 8) * (G / 8) + bx / 8 : bx;
#define GRID_SYNC() do { xcd_barrier(xbar); } while (0)
    unsigned grp_gen = 0u;
    volatile LAS unsigned* xb_st = (volatile LAS unsigned*)(ldsl + LDS_BYTES - 16);
    if (threadIdx.x < 2) xb_st[threadIdx.x] = 0u;
    __syncthreads();
    const XcdBarrier xbar = xcd_barrier_post((unsigned*)args.ws + 4224, xb_st);
#define GROUP_SYNC() do { if (gridDim.x == 256) { ++grp_gen; own_grid_barrier((unsigned*)args.ws + 64 * (1 + (blockIdx.x & 63)), grp_gen * 4u, !grp_same); } else GRID_SYNC(); } while (0)
    unsigned* xcc_tab = (unsigned*)args.ws + 8192;
    const unsigned my_xcc = (unsigned)__builtin_amdgcn_s_getreg((3 << 11) | 20) & 0xFu;
    if (threadIdx.x == 0) __hip_atomic_store(xcc_tab + blockIdx.x, my_xcc, __ATOMIC_RELAXED, __HIP_MEMORY_SCOPE_AGENT);
    bool grp_same = false;
    if (args.ws == nullptr) grid.sync();
    typedef const __attribute__((address_space(4))) Args* KArgs;
    const KArgs kp0 = (KArgs)__builtin_amdgcn_kernarg_segment_ptr();
#define PHASE_ARGS() KArgs kp = kp0; asm volatile("" : "+s"(kp)); unsigned char* ws = kp->ws; (void)ws
    {
        PHASE_ARGS(); PHASE_TID();
        const float* x = kp->in[0]; const float* g_mix = kp->in[1]; const float* w_in = kp->in[2]; const float* w_gate = kp->in[12];
        float* ROPE = (float*)(ws + WS_ROPE); bf16* W1t = (bf16*)(ws + WS_W1); bf16* XN = (bf16*)(ws + WS_XN);
        LAS float* scr = (LAS float*)(ldsl + wave * 18432);
        const int gw = vcu * NWAVES + wave, NGW = G * NWAVES;
        constexpr int I_W1 = 16 * (NPG / 64);
        for (int r = gw; r < I_W1; r += NGW) {
            const int nb = NPG / 64, k0 = 64 * (r / nb), d0 = 64 * (r % nb), tile = d0 >> 8, p = d0 & 255, cA = tile * 256 + 64 * ((p >> 5) & 3) + 32 * (p >> 7), cB = cA + 64;
            if (tile < 12) tr_item64(w_in, 3072, cA, cB, k0, W1t, 1024, d0, nullptr, scr, lane);
            else { const int gcol = (p >> 7) * 1024 + (tile - 12) * 128 + (p & 127); tr_item64(w_gate, 2048, gcol, gcol + 32, k0, W1t, 1024, d0, nullptr, scr, lane); }
        }
        for (int m0 = gw; m0 < M; m0 += 2 * NGW) {
            const int m1 = (m0 + NGW < M) ? m0 + NGW : m0;
            const f32x4* xr0 = (const f32x4*)(x + (size_t)m0 * D) + lane; const f32x4* xr1 = (const f32x4*)(x + (size_t)m1 * D) + lane; const f32x4* gr = (const f32x4*)g_mix + lane;
            f32x4 v0[4], v1[4]; float s0 = 0.f, s1 = 0.f;
#pragma unroll
            for (int j = 0; j < 4; ++j) { v0[j] = xr0[64 * j]; v1[j] = xr1[64 * j]; }
#pragma unroll
            for (int j = 0; j < 4; ++j) { s0 += (v0[j].x * v0[j].x + v0[j].y * v0[j].y) + (v0[j].z * v0[j].z + v0[j].w * v0[j].w); s1 += (v1[j].x * v1[j].x + v1[j].y * v1[j].y) + (v1[j].z * v1[j].z + v1[j].w * v1[j].w); }
            const float r0 = __builtin_amdgcn_rsqf(wave_sum(s0) * (1.f / D) + 1e-6f), r1 = __builtin_amdgcn_rsqf(wave_sum(s1) * (1.f / D) + 1e-6f);
            unsigned long long* o0 = (unsigned long long*)(XN + (size_t)m0 * D) + lane; unsigned long long* o1 = (unsigned long long*)(XN + (size_t)m1 * D) + lane;
#pragma unroll
            for (int j = 0; j < 4; ++j) { const f32x4 g = gr[64 * j];
                o0[64 * j] = (unsigned long long)pk2(v0[j].x * r0 * g.x, v0[j].y * r0 * g.y) | ((unsigned long long)pk2(v0[j].z * r0 * g.z, v0[j].w * r0 * g.w) << 32);
                o1[64 * j] = (unsigned long long)pk2(v1[j].x * r1 * g.x, v1[j].y * r1 * g.y) | ((unsigned long long)pk2(v1[j].z * r1 * g.z, v1[j].w * r1 * g.w) << 32); }
        }
        for (int i = (vcu * NWAVES + wave) * 64 + lane; i < SEQ * 8; i += G * NWAVES * 64) {
            const int pos = i >> 3, idx = i & 7;
            const float invf = __builtin_amdgcn_exp2f(-2.3664460711655217f * (float)idx); const float ang = (float)pos * invf;
            const double rev = (double)ang * 0.15915494309189535; const float fr = (float)(rev - __builtin_floor(rev));
            ROPE[2 * i] = __builtin_amdgcn_cosf(fr); ROPE[2 * i + 1] = __builtin_amdgcn_sinf(fr);
        }
    }
    GRID_SYNC();
    if (gridDim.x == 256) { const unsigned g_ = blockIdx.x & 63; unsigned eq_ = 1u;
        for (int k = 0; k < 4; ++k) eq_ &= (__hip_atomic_load(xcc_tab + g_ + 64 * k, __ATOMIC_RELAXED, __HIP_MEMORY_SCOPE_AGENT) == my_xcc) ? 1u : 0u;
        grp_same = __builtin_amdgcn_readfirstlane(eq_) != 0u; }

    {
        PHASE_ARGS(); PHASE_TID();
        const float* g_q = kp->in[3]; const float* g_k = kp->in[4]; const float* b_gate = kp->in[13];
        float* ROPE = (float*)(ws + WS_ROPE); bf16* W1t = (bf16*)(ws + WS_W1); bf16* XN = (bf16*)(ws + WS_XN); bf16* PROJ = (bf16*)(ws + WS_PROJ); bf16* GATES = (bf16*)(ws + WS_GATES);
        pg8::Gemm g{XN, W1t, M, NPG, D}; pg8::StaticOrder S; S.init(M, NPG, G, bx);
        pg8::EpiProj E{PROJ, GATES, b_gate, g_q, g_k, ROPE};
        pg8::gemm_phase<pg8::EpiProj, pg8::StaticOrder, true, true>(ldsl, g, S, E);
    }
    GRID_SYNC();

    {
        PHASE_ARGS(); PHASE_TID();
        const float* lam_q1 = kp->in[5]; const float* lam_k1 = kp->in[6]; const float* lam_q2 = kp->in[7]; const float* lam_k2 = kp->in[8]; const float* g_sub = kp->in[9];
        bf16* OAB = (bf16*)(ws + WS_XN); bf16* PROJ = (bf16*)(ws + WS_PROJ);
        const float d1 = wave_sum(lam_q1[lane] * lam_k1[lane]), d2 = wave_sum(lam_q2[lane] * lam_k2[lane]);
        const float lam = __expf(d1) - __expf(d2) + 0.2f;
        for (int v = vcu; v < 256; v += G) {
            const int xg = v >> 5, j = v & 31;
            att::da_unit(xg >> 2, xg & 3, j, PROJ, OAB, (char*)lds, lam, g_sub);
            {
                KArgs kq = kp0; asm volatile("" : "+s"(kq)); unsigned char* wsq = kq->ws;
                const float* w_ba = kq->in[10]; const float* w_bb = kq->in[11]; const float* w_out = kq->in[14]; const float* g_ffn = kq->in[15]; const float* w_fg = kq->in[16]; const float* w_fu = kq->in[17]; const float* w_fd = kq->in[18];
                bf16* WABt = (bf16*)(wsq + WS_WAB); bf16* WOUTt = (bf16*)(wsq + WS_WOUT); bf16* WGUt = (bf16*)(wsq + WS_WGU); bf16* WDt = (bf16*)(wsq + WS_WD);
                LAS float* scr = (LAS float*)(ldsl + wave * 18432);
                constexpr int I_WAB = 2 * 8 * 16, I_WOUT = 16 * 16, I_WGU = 16 * (NGU / 64), I_WD = (FF / 64) * 16, NDEF = I_WAB + I_WOUT + I_WGU + I_WD;
                for (int it = v * NWAVES + wave; it < NDEF; it += 256 * NWAVES) {
                    int r = it; const float* src; const float* gk = nullptr; bf16* dst; int srcN, col, k0, d0, K = 1024;
                    if (r < I_WAB) { const int mat = r >> 7, rr = r & 127; k0 = 64 * (rr >> 4); d0 = 64 * (rr & 15); src = mat ? w_bb : w_ba; srcN = 1024; col = d0; dst = WABt + (mat ? 512 : 0); }
                    else if ((r -= I_WAB) < I_WOUT) { k0 = 64 * (r >> 4); d0 = 64 * (r & 15); src = w_out; srcN = 1024; col = d0; dst = WOUTt; }
                    else if ((r -= I_WOUT) < I_WGU) { const int nb = NGU / 64; k0 = 64 * (r / nb); d0 = 64 * (r % nb); const int tile = d0 >> 8, p = d0 & 255; col = tile * 128 + (p & 127); src = (p >> 7) ? w_fu : w_fg; srcN = FF; dst = WGUt; gk = g_ffn; }
                    else { r -= I_WGU; k0 = 64 * (r >> 4); d0 = 64 * (r & 15); src = w_fd; srcN = 1024; col = d0; dst = WDt; K = FF; }
                    tr_item64(src, srcN, col, col + 32, k0, dst, K, d0, gk, scr, lane);
                }
                __syncthreads();
            }
            att::da_unit((xg + 8) >> 2, (xg + 8) & 3, 31 - j, PROJ, OAB, (char*)lds, lam, g_sub);
        }
        for (int v = vcu; v < 256; v += G)
            for (int i = 0; i < 2; ++i) { const int id = v * 2 + i, bg = id >> 6, c = (i == 0) ? (id & 63) : 63 - ((id - 1) & 63); att::sb_unit(bg >> 1, bg & 1, c, PROJ, OAB, (char*)lds); }
    }
    GRID_SYNC();

    {
        PHASE_ARGS(); PHASE_TID();
        bf16* OAB = (bf16*)(ws + WS_XN); bf16* WABt = (bf16*)(ws + WS_WAB); bf16* MERGED = (bf16*)(ws + WS_MERGED); bf16* GATES = (bf16*)(ws + WS_GATES);
        pg8::Gemm g{OAB, WABt, M, D, D}; pg8::StaticOrder S; S.init(M, D, G, bx);
        pg8::EpiMerge E{MERGED, GATES};
        pg8::gemm_phase<pg8::EpiMerge, pg8::StaticOrder, true, true>(ldsl, g, S, E);
    }
    GROUP_SYNC();

    {
        PHASE_ARGS(); PHASE_TID();
        const float* x = kp->in[0]; float* SSQ = (float*)(ws + WS_SSQ); bf16* WOUTt = (bf16*)(ws + WS_WOUT); bf16* MERGED = (bf16*)(ws + WS_MERGED); bf16* X1B = (bf16*)(ws + WS_XN);
        pg8::Gemm g{MERGED, WOUTt, M, D, D}; pg8::StaticOrder S; S.init(M, D, G, bx);
        pg8::EpiWout E{x, X1B, SSQ};
        pg8::gemm_phase<pg8::EpiWout, pg8::StaticOrder, true, true>(ldsl, g, S, E);
    }
    GROUP_SYNC();

    {
        PHASE_ARGS(); PHASE_TID();
        float* SSQ = (float*)(ws + WS_SSQ); bf16* WGUt = (bf16*)(ws + WS_WGU); bf16* X1B = (bf16*)(ws + WS_XN); bf16* FFB = (bf16*)(ws + WS_FF);
        pg8::Gemm g{X1B, WGUt, M, NGU, D}; pg8::StaticOrder S; S.init(M, NGU, G, bx);
        pg8::EpiFfnUp E{FFB, SSQ};
        pg8::gemm_phase<pg8::EpiFfnUp, pg8::StaticOrder, true, true>(ldsl, g, S, E);
    }
    GROUP_SYNC();

    {
        PHASE_ARGS(); PHASE_TID();
        float* out = kp->out; bf16* WDt = (bf16*)(ws + WS_WD); bf16* FFB = (bf16*)(ws + WS_FF); const bf16* X1B = (const bf16*)(ws + WS_XN);
        pg8::Gemm g{FFB, WDt, M, D, FF}; pg8::StaticOrder S; S.init(M, D, G, bx);
        pg8::EpiDown E{out, X1B};
        pg8::gemm_phase<pg8::EpiDown, pg8::StaticOrder, true, true>(ldsl, g, S, E);
    }
}

extern "C" void kernel_launch(void* const* d_in, const int* in_sizes, int n_in, void* d_out, int out_size, void* d_ws, size_t ws_size, hipStream_t stream) {
    static int grid = 0;
    if (grid == 0) {
        if (n_in != 19 || in_sizes[0] != M * D || out_size != M * D || ws_size < WS_END) { fprintf(stderr, "kernel_launch: unexpected shapes (n_in %d, in0 %d, out %d, ws %zu); nothing launched\n", n_in, n_in > 0 ? in_sizes[0] : -1, out_size, ws_size); grid = -1; return; }
        int dev = 0, cus = 0, per_cu = 0;
        if (hipGetDevice(&dev) != hipSuccess || hipDeviceGetAttribute(&cus, hipDeviceAttributeMultiprocessorCount, dev) != hipSuccess) { grid = -1; return; }
        if (hipFuncSetAttribute((const void*)mk_fwd, hipFuncAttributeMaxDynamicSharedMemorySize, LDS_BYTES) != hipSuccess) { fprintf(stderr, "kernel_launch: hipFuncSetAttribute failed\n"); grid = -1; return; }
        if (hipOccupancyMaxActiveBlocksPerMultiprocessor(&per_cu, (const void*)mk_fwd, NWAVES * 64, LDS_BYTES) != hipSuccess || per_cu < 1) { (void)hipGetLastError(); per_cu = 1; }
        grid = cus * per_cu;
    }
    if (grid < 0) return;
    if (hipMemsetAsync(d_ws, 0, 32768, stream) != hipSuccess) { fprintf(stderr, "kernel_launch: hipMemsetAsync failed\n"); return; }
    Args a{};
    for (int i = 0; i < 19; ++i) a.in[i] = (const float*)d_in[i];
    a.out = (float*)d_out; a.ws = (unsigned char*)d_ws;
    void* kargs[] = {&a};
    const hipError_t e = hipLaunchCooperativeKernel((const void*)mk_fwd, dim3(grid), dim3(NWAVES * 64), kargs, LDS_BYTES, stream);
    if (e != hipSuccess) fprintf(stderr, "kernel_launch: cooperative launch failed: %s (grid %d)\n", hipGetErrorString(e), grid);
}
```

```cpp
#include <hip/hip_runtime.h>
#include <hip/hip_cooperative_groups.h>
#include <cstdio>
#include <cstdint>
#include <cmath>
namespace pg8 {
#define PG8_LAS __attribute__((address_space(3)))
typedef unsigned short bf16_t;
typedef short bf16x8 __attribute__((ext_vector_type(8)));
typedef float f32x4 __attribute__((ext_vector_type(4)));
typedef unsigned u32x4 __attribute__((ext_vector_type(4)));
constexpr int BM = 256, BK = 64, HALF = 128, HTB = HALF * BK * 2  , STAGE_BYTES = 8 * HTB, NXCD = 8, WGM = 8;

__host__ __device__ __forceinline__ int lds_byte(int r, int c) { const int st = (r >> 4) * 2 + (c >> 5), rr = r & 15, cc = c & 31, ob = rr * 64 + cc * 2; return st * 1024 + (ob ^ (((ob >> 9) & 1) << 5)); }
__host__ __device__ __forceinline__ void stage_rc(int b, int& R, int& C) { const int st = b / 1024, sb = b % 1024, swz = sb ^ (((sb >> 9) & 1) << 5); R = (st >> 1) * 16 + swz / 64; C = (st & 1) * 32 + (swz % 64) / 2; }
__host__ __device__ __forceinline__ int perm32(int rho) { const int n = rho >> 4, i = rho & 15; return 8 * (i >> 2) + 4 * n + (i & 3); }

struct Unit { int pm, pn; };
struct Gemm { const bf16_t* A; const bf16_t* Bt; int M, N, K; };

struct StaticOrder {
    int nM, nN, nwg, G, c;
    __host__ __device__ void init(int M, int N, int G_, int c_) { nM = M / BM; nN = N / BM; nwg = nM * nN; G = G_; c = c_; }
    __host__ __device__ bool next(int i, Unit& u) const {
        const long L = (long)i * G + c; if (L >= nwg) return false;
        int wgid = (int)L; { const int q = nwg / NXCD, r = nwg % NXCD, xcd = wgid % NXCD, off = wgid / NXCD; wgid = (xcd < r ? xcd * (q + 1) : r * (q + 1) + (xcd - r) * q) + off; }
        const int nig = WGM * nN, gid = wgid / nig, fm = gid * WGM, gsz = (nM - fm) < WGM ? (nM - fm) : WGM;
        u.pm = fm + ((wgid % nig) % gsz); u.pn = (wgid % nig) / gsz; return true;
    }
    __device__ __forceinline__ void a_ready(const Unit&) const {}
    __device__ __forceinline__ void done(const Unit&) const {}
};

typedef __bf16 bf16x2_cv __attribute__((ext_vector_type(2))); typedef float f32x2_cv __attribute__((ext_vector_type(2)));
__device__ __forceinline__ unsigned cvt_pk_bf16(float lo, float hi) { f32x2_cv v = {lo, hi}; bf16x2_cv b = __builtin_convertvector(v, bf16x2_cv); return __builtin_bit_cast(unsigned, b); }
typedef float f32x2 __attribute__((ext_vector_type(2)));
typedef unsigned u32x2 __attribute__((ext_vector_type(2)));
__device__ __forceinline__ float bf_lo(unsigned w) { return __uint_as_float(w << 16); }
__device__ __forceinline__ float bf_hi(unsigned w) { return __uint_as_float(w & 0xffff0000u); }
__device__ __forceinline__ float sigmoidf_fast(float x) { return __builtin_amdgcn_rcpf(1.0f + __builtin_amdgcn_exp2f(-1.4426950408889634f * x)); }
constexpr float QC2 = 0.125f * 1.4426950408889634f;
constexpr int PROJ_PITCH = 3072, GATE_PITCH = 2048;

struct EpiProj {
    static constexpr bool PERM = true, AFTER_DRAIN = false, MIDHOOK = false;
    bf16_t* proj; bf16_t* gates; const float* bgate; const float* gq; const float* gk; const float* rope;
    __device__ __forceinline__ void operator()(const f32x4 (&acc)[2][2][4][2], const Unit& u, int wr, int wc, int fr, int fq) const {
        const int row0 = u.pm * BM + wr * 64 + fr, pn = u.pn;
        const int lcol = pn * 256 + 64 * wc + 8 * fq;
        if (pn >= 12) {
            const int ch0 = (pn - 12) * 128 + 32 * wc + 8 * fq;
            f32x4 bv[2][2];
#pragma unroll
            for (int bj = 0; bj < 2; ++bj)
#pragma unroll
                for (int n = 0; n < 2; ++n) bv[bj][n] = *(const f32x4*)(bgate + bj * 1024 + ch0 + 4 * n);
#pragma unroll
            for (int ai = 0; ai < 2; ++ai)
#pragma unroll
                for (int m = 0; m < 4; ++m) { bf16_t* rowp = gates + (size_t)(row0 + ai * HALF + m * 16) * GATE_PITCH + ch0;
                    float rr[8], gg[8];
#pragma unroll
                    for (int n = 0; n < 2; ++n)
#pragma unroll
                        for (int i = 0; i < 4; ++i) { const float e0 = __builtin_amdgcn_exp2f(-1.4426950408889634f * (acc[ai][0][m][n][i] + bv[0][n][i]));
                            const float e1 = __builtin_fminf(__builtin_amdgcn_exp2f(-1.4426950408889634f * (acc[ai][1][m][n][i] + bv[1][n][i])), 1e20f);
                            rr[4 * n + i] = (1.0f + e1) * __builtin_amdgcn_rcpf(1.0f + e0); gg[4 * n + i] = __builtin_amdgcn_rcpf(1.0f + e1); }
                    u32x4 w; w.x = cvt_pk_bf16(rr[0], rr[1]); w.y = cvt_pk_bf16(rr[2], rr[3]); w.z = cvt_pk_bf16(rr[4], rr[5]); w.w = cvt_pk_bf16(rr[6], rr[7]);
                    *(u32x4*)rowp = w;
                    w.x = cvt_pk_bf16(gg[0], gg[1]); w.y = cvt_pk_bf16(gg[2], gg[3]); w.z = cvt_pk_bf16(gg[4], gg[5]); w.w = cvt_pk_bf16(gg[6], gg[7]);
                    *(u32x4*)(rowp + 1024) = w; }
        } else if (pn >= 6 && pn < 10) {
            const float* g = (pn < 8) ? gq : gk; const float sc = (pn < 8) ? QC2 : 1.0f;
            f32x4 gv[2][2];
#pragma unroll
            for (int bj = 0; bj < 2; ++bj)
#pragma unroll
                for (int n = 0; n < 2; ++n) gv[bj][n] = *(const f32x4*)(g + 32 * bj + 8 * fq + 4 * n);
#pragma unroll
            for (int ai = 0; ai < 2; ++ai)
#pragma unroll
                for (int m = 0; m < 4; ++m) { const int row = row0 + ai * HALF + m * 16, pos = row & 4095;
                    float ss = 0.f;
#pragma unroll
                    for (int bj = 0; bj < 2; ++bj)
#pragma unroll
                        for (int n = 0; n < 2; ++n) { const f32x4 x = acc[ai][bj][m][n]; ss += (x[0] * x[0] + x[1] * x[1]) + (x[2] * x[2] + x[3] * x[3]); }
                    ss += __shfl_xor(ss, 16); ss += __shfl_xor(ss, 32);
                    const float rstd = __builtin_amdgcn_rsqf(ss * (1.0f / 64.0f) + 1e-6f);
                    f32x4 v[2][2];
#pragma unroll
                    for (int bj = 0; bj < 2; ++bj)
#pragma unroll
                        for (int n = 0; n < 2; ++n) v[bj][n] = acc[ai][bj][m][n] * rstd * gv[bj][n];
#pragma unroll
                    for (int n = 0; n < 2; ++n) { const f32x4 cs0 = *(const f32x4*)(rope + (size_t)pos * 16 + 8 * n), cs1 = *(const f32x4*)(rope + (size_t)pos * 16 + 8 * n + 4);
                        const float c[4] = {cs0[0], cs0[2], cs1[0], cs1[2]}, s[4] = {cs0[1], cs0[3], cs1[1], cs1[3]};
#pragma unroll
                        for (int i = 0; i < 4; ++i) { const float own = v[0][n][i], oth = __shfl_xor(own, 16);
                            const float r0 = own * c[i] - oth * s[i], r1 = own * c[i] + oth * s[i];
                            v[0][n][i] = (fq == 0) ? r0 : ((fq == 1) ? r1 : own); } }
                    bf16_t* rowp = proj + (size_t)row * PROJ_PITCH + lcol;
#pragma unroll
                    for (int bj = 0; bj < 2; ++bj) { const f32x4 v0 = v[bj][0] * sc, v1 = v[bj][1] * sc;
                        u32x4 w; w.x = cvt_pk_bf16(v0[0], v0[1]); w.y = cvt_pk_bf16(v0[2], v0[3]); w.z = cvt_pk_bf16(v1[0], v1[1]); w.w = cvt_pk_bf16(v1[2], v1[3]);
                        *(u32x4*)(rowp + 32 * bj) = w; } }
        } else {
            const float sc = (pn < 2) ? QC2 : 1.0f;
#pragma unroll
            for (int ai = 0; ai < 2; ++ai)
#pragma unroll
                for (int m = 0; m < 4; ++m) { bf16_t* rowp = proj + (size_t)(row0 + ai * HALF + m * 16) * PROJ_PITCH + lcol;
#pragma unroll
                    for (int bj = 0; bj < 2; ++bj) { const f32x4 v0 = acc[ai][bj][m][0] * sc, v1 = acc[ai][bj][m][1] * sc;
                        u32x4 w; w.x = cvt_pk_bf16(v0[0], v0[1]); w.y = cvt_pk_bf16(v0[2], v0[3]); w.z = cvt_pk_bf16(v1[0], v1[1]); w.w = cvt_pk_bf16(v1[2], v1[3]);
                        *(u32x4*)(rowp + 32 * bj) = w; } }
        }
    }
};

struct EpiMerge {
    static constexpr bool PERM = true, AFTER_DRAIN = false, MIDHOOK = true;
    bf16_t* merged; const bf16_t* gates;
    __device__ __forceinline__ void mid(f32x4 (&acc)[2][2][4][2], const Unit& u, int wr, int wc, int fr, int fq) const {
        int fr_l = fr; asm volatile("" : "+v"(fr_l));
        const int row0 = u.pm * BM + wr * 64 + fr_l, col0 = u.pn * BM + wc * 32 + 8 * fq;
#pragma unroll
        for (int ai = 0; ai < 2; ++ai) {
#pragma unroll
            for (int m = 0; m < 4; ++m) { const bf16_t* gp = gates + (size_t)(row0 + ai * HALF + m * 16) * GATE_PITCH + col0;
#pragma unroll
                for (int bj = 0; bj < 2; ++bj) { const u32x4 a = *(const u32x4*)(gp + bj * HALF);
                    acc[ai][bj][m][0][0] *= bf_lo(a.x); acc[ai][bj][m][0][1] *= bf_hi(a.x); acc[ai][bj][m][0][2] *= bf_lo(a.y); acc[ai][bj][m][0][3] *= bf_hi(a.y);
                    acc[ai][bj][m][1][0] *= bf_lo(a.z); acc[ai][bj][m][1][1] *= bf_hi(a.z); acc[ai][bj][m][1][2] *= bf_lo(a.w); acc[ai][bj][m][1][3] *= bf_hi(a.w); } }
            asm volatile("" ::: "memory"); }
    }
    __device__ __forceinline__ void operator()(const f32x4 (&acc)[2][2][4][2], const Unit& u, int wr, int wc, int fr, int fq) const {
        const int row0 = u.pm * BM + wr * 64 + fr, col0 = u.pn * BM + wc * 32 + 8 * fq;
#pragma unroll
        for (int ai = 0; ai < 2; ++ai)
#pragma unroll
            for (int m = 0; m < 4; ++m) { const size_t row = (size_t)(row0 + ai * HALF + m * 16);
#pragma unroll
                for (int bj = 0; bj < 2; ++bj) { const int col = col0 + bj * HALF; const u32x4 b = *(const u32x4*)(gates + row * GATE_PITCH + 1024 + col);
                    const f32x4 v0 = acc[ai][bj][m][0], v1 = acc[ai][bj][m][1];
                    u32x4 w; w.x = cvt_pk_bf16(v0[0] * bf_lo(b.x), v0[1] * bf_hi(b.x)); w.y = cvt_pk_bf16(v0[2] * bf_lo(b.y), v0[3] * bf_hi(b.y));
                    w.z = cvt_pk_bf16(v1[0] * bf_lo(b.z), v1[1] * bf_hi(b.z)); w.w = cvt_pk_bf16(v1[2] * bf_lo(b.w), v1[3] * bf_hi(b.w));
                    *(u32x4*)(merged + row * 1024 + col) = w; } }
    }
};

struct EpiWout {
    static constexpr bool PERM = true, AFTER_DRAIN = false, MIDHOOK = false;
    const float* x; bf16_t* x1b; float* ssq;
    __device__ __forceinline__ void operator()(const f32x4 (&acc)[2][2][4][2], const Unit& u, int wr, int wc, int fr, int fq) const {
        const int row0 = u.pm * BM + wr * 64 + fr, col0 = u.pn * BM + wc * 32 + 8 * fq;
#pragma unroll
        for (int ai = 0; ai < 2; ++ai)
#pragma unroll
            for (int m = 0; m < 4; ++m) { const size_t row = (size_t)(row0 + ai * HALF + m * 16); float ss = 0.f;
#pragma unroll
                for (int bj = 0; bj < 2; ++bj) { const size_t off = row * 1024 + col0 + bj * HALF;
                    const f32x4 v0 = *(const f32x4*)(x + off) + acc[ai][bj][m][0], v1 = *(const f32x4*)(x + off + 4) + acc[ai][bj][m][1];
                    ss += (v0[0] * v0[0] + v0[1] * v0[1]) + (v0[2] * v0[2] + v0[3] * v0[3]) + (v1[0] * v1[0] + v1[1] * v1[1]) + (v1[2] * v1[2] + v1[3] * v1[3]);
                    u32x4 w; w.x = cvt_pk_bf16(v0[0], v0[1]); w.y = cvt_pk_bf16(v0[2], v0[3]); w.z = cvt_pk_bf16(v1[0], v1[1]); w.w = cvt_pk_bf16(v1[2], v1[3]);
                    *(u32x4*)(x1b + off) = w; }
                ss += __shfl_xor(ss, 16); ss += __shfl_xor(ss, 32);
                if (fq == 0) ssq[row * 16 + u.pn * 4 + wc] = ss; }
    }
};
struct EpiFfnUp {
    static constexpr bool PERM = true, AFTER_DRAIN = false, MIDHOOK = false;
    bf16_t* ff; const float* ssq;
    __device__ __forceinline__ void operator()(const f32x4 (&acc)[2][2][4][2], const Unit& u, int wr, int wc, int fr, int fq) const {
        const int row0 = u.pm * BM + wr * 64 + fr, col0 = u.pn * 128 + wc * 32 + 8 * fq;
#pragma unroll
        for (int ai = 0; ai < 2; ++ai)
#pragma unroll
            for (int m = 0; m < 4; ++m) { const size_t row = (size_t)(row0 + ai * HALF + m * 16);
                const f32x4 s0 = *(const f32x4*)(ssq + row * 16), s1 = *(const f32x4*)(ssq + row * 16 + 4), s2 = *(const f32x4*)(ssq + row * 16 + 8), s3 = *(const f32x4*)(ssq + row * 16 + 12);
                const f32x4 st = (s0 + s1) + (s2 + s3);
                const float rstd = __builtin_amdgcn_rsqf(((st[0] + st[1]) + (st[2] + st[3])) * (1.0f / 1024.0f) + 1e-6f);
                float o[8];
#pragma unroll
                for (int n = 0; n < 2; ++n)
#pragma unroll
                    for (int i = 0; i < 4; ++i) { const float g = acc[ai][0][m][n][i] * rstd, up = acc[ai][1][m][n][i] * rstd; o[4 * n + i] = g * sigmoidf_fast(g) * up; }
                u32x4 w; w.x = cvt_pk_bf16(o[0], o[1]); w.y = cvt_pk_bf16(o[2], o[3]); w.z = cvt_pk_bf16(o[4], o[5]); w.w = cvt_pk_bf16(o[6], o[7]);
                *(u32x4*)(ff + row * 2816 + col0) = w; }
    }
};
struct EpiDown {
    static constexpr bool PERM = true, AFTER_DRAIN = false, MIDHOOK = false;
    float* out; const bf16_t* x1b;
    __device__ __forceinline__ void operator()(const f32x4 (&acc)[2][2][4][2], const Unit& u, int wr, int wc, int fr, int fq) const {
        const int row0 = u.pm * BM + wr * 64 + fr, col0 = u.pn * BM + wc * 32 + 8 * fq;
#pragma unroll
        for (int ai = 0; ai < 2; ++ai)
#pragma unroll
            for (int m = 0; m < 4; ++m) { const size_t row = (size_t)(row0 + ai * HALF + m * 16);
#pragma unroll
                for (int bj = 0; bj < 2; ++bj) { const size_t off = row * 1024 + col0 + bj * HALF; const u32x4 w = *(const u32x4*)(x1b + off);
                    f32x4 v0 = acc[ai][bj][m][0], v1 = acc[ai][bj][m][1];
                    v0[0] += bf_lo(w.x); v0[1] += bf_hi(w.x); v0[2] += bf_lo(w.y); v0[3] += bf_hi(w.y); v1[0] += bf_lo(w.z); v1[1] += bf_hi(w.z); v1[2] += bf_lo(w.w); v1[3] += bf_hi(w.w);
                    *(f32x4*)(out + off) = v0; *(f32x4*)(out + off + 4) = v1; } }
    }
};

template <class Epi, class Sched, bool ALIGN_EPI = false, bool SP2 = false>
__device__ __forceinline__ void gemm_phase(PG8_LAS unsigned char* lds, const Gemm g, const Sched& S, const Epi& E) {
    int tid_l = threadIdx.x; asm volatile("" : "+v"(tid_l));
    const int tid = tid_l, wid = __builtin_amdgcn_readfirstlane(tid >> 6), lane = tid & 63, wr = wid >> 2, wc = wid & 3, fr = lane & 15, fq = lane >> 4;
    const int K = g.K, nt = K / BK;
    unsigned voffA[2], voffB[2];
#pragma unroll
    for (int i = 0; i < 2; ++i) { int R, C; stage_rc(tid * 16 + i * 8192, R, C); const int Rb = Epi::PERM ? ((R & ~31) + perm32(R & 31)) : R;
        voffA[i] = (unsigned)(R * K + C) * 2u; voffB[i] = (unsigned)(Rb * K + C) * 2u; }
    const size_t kstep = (size_t)(BK * 2);
    const size_t hstep = (size_t)HALF * K * 2;
    const size_t tstep = 2 * hstep;
    const unsigned ldsw = (unsigned)wid * 1024u;
    const int aoff = lds_byte(wr * 64 + fr, fq * 8), boff = lds_byte(wc * 32 + fr, fq * 8);
#define PG8_SA(b, h) (((b) * 2 + (h)) * HTB)
#define PG8_SB(b, h) ((4 + (b) * 2 + (h)) * HTB)
#define PG8_STAGE(bufoff, gbase, voff) do { _Pragma("unroll") for (int _i = 0; _i < 2; ++_i) \
        __builtin_amdgcn_global_load_lds((const unsigned*)((const char*)(gbase) + (voff)[_i]), (PG8_LAS unsigned*)(lds + (bufoff) + ldsw + _i * 8192), 16, 0, 0); } while (0)
#define PG8_LDA(dst, b, h) do { _Pragma("unroll") for (int m = 0; m < 4; ++m) _Pragma("unroll") for (int k = 0; k < 2; ++k) dst[m][k] = *(const PG8_LAS bf16x8*)(lds + PG8_SA(b, h) + aoff + m * 2048 + k * 1024); } while (0)
#define PG8_LDB(dst, b, h) do { _Pragma("unroll") for (int n = 0; n < 2; ++n) _Pragma("unroll") for (int k = 0; k < 2; ++k) dst[n][k] = *(const PG8_LAS bf16x8*)(lds + PG8_SB(b, h) + boff + n * 2048 + k * 1024); } while (0)
#define PG8_MMA(ai, bj, At, Bt) do { __builtin_amdgcn_s_setprio(1); _Pragma("unroll") for (int m = 0; m < 4; ++m) _Pragma("unroll") for (int n = 0; n < 2; ++n) _Pragma("unroll") for (int k = 0; k < 2; ++k) \
        acc[ai][bj][m][n] = __builtin_amdgcn_mfma_f32_16x16x32_bf16(Bt[n][k], At[m][k], acc[ai][bj][m][n], 0, 0, 0); __builtin_amdgcn_s_setprio(0); } while (0)
#define PG8_WAIT_V(n) asm volatile("s_waitcnt vmcnt(" #n ")" ::: "memory")
#define PG8_WAIT_L(n) asm volatile("s_waitcnt lgkmcnt(" #n ")" ::: "memory")
#define PG8_BAR __builtin_amdgcn_s_barrier()
#define PG8_SCHED __builtin_amdgcn_sched_barrier(0)
    Unit cur, nxt; int ui = 0;
    if (!S.next(0, cur)) return;
    f32x4 acc[2][2][4][2];
#pragma unroll
    for (int a = 0; a < 2; ++a)
#pragma unroll
        for (int b = 0; b < 2; ++b)
#pragma unroll
            for (int m = 0; m < 4; ++m)
#pragma unroll
                for (int n = 0; n < 2; ++n) acc[a][b][m][n] = (f32x4){0.f, 0.f, 0.f, 0.f};
    bf16x8 At[4][2], B0[2][2], B1[2][2];
    const char* cA = (const char*)g.A + (size_t)cur.pm * tstep; const char* cB = (const char*)g.Bt + (size_t)cur.pn * tstep;
    S.a_ready(cur);
    if constexpr (SP2) {
        PG8_STAGE(PG8_SB(0, 0), cB, voffB); PG8_STAGE(PG8_SB(0, 1), cB + hstep, voffB); PG8_STAGE(PG8_SA(0, 0), cA, voffA); PG8_STAGE(PG8_SA(0, 1), cA + hstep, voffA);
        if (wr == 1) PG8_BAR;
        PG8_WAIT_V(2); PG8_BAR;
        PG8_STAGE(PG8_SB(1, 0), cB + kstep, voffB); PG8_STAGE(PG8_SA(1, 0), cA + kstep, voffA); PG8_STAGE(PG8_SB(1, 1), cB + hstep + kstep, voffB);
        PG8_WAIT_V(6); PG8_BAR;
    } else {
        PG8_STAGE(PG8_SB(0, 0), cB, voffB); PG8_STAGE(PG8_SA(0, 0), cA, voffA); PG8_STAGE(PG8_SB(0, 1), cB + hstep, voffB); PG8_STAGE(PG8_SA(0, 1), cA + hstep, voffA);
        if (wr == 1) PG8_BAR;
        PG8_WAIT_V(4); PG8_BAR;
        PG8_STAGE(PG8_SB(1, 0), cB + kstep, voffB); PG8_STAGE(PG8_SA(1, 0), cA + kstep, voffA); PG8_STAGE(PG8_SB(1, 1), cB + hstep + kstep, voffB);
        PG8_WAIT_V(6); PG8_BAR;
    }
    for (;;) {
        const bool has_next = S.next(ui + 1, nxt);
        const char* nA = has_next ? (const char*)g.A + (size_t)nxt.pm * tstep : cA; const char* nB = has_next ? (const char*)g.Bt + (size_t)nxt.pn * tstep : cB;
        for (int t = 0; t < nt; t += 2) {
            if constexpr (Epi::MIDHOOK) { if (t == (nt >> 1)) E.mid(acc, cur, wr, wc, fr, fq); }
            const bool last = (t == nt - 2);
            const char* a1 = cA + (size_t)(t + 1) * kstep;
            const char* a2 = last ? nA : cA + (size_t)(t + 2) * kstep; const char* b2 = last ? nB : cB + (size_t)(t + 2) * kstep;
            const char* a3 = a2 + kstep; const char* b3 = b2 + kstep;
            if (last && has_next) S.a_ready(nxt);
            if constexpr (SP2) {
            PG8_LDB(B0, 0, 0); PG8_LDB(B1, 0, 1); PG8_SCHED; PG8_LDA(At, 0, 0); PG8_STAGE(PG8_SA(1, 1), a1 + hstep, voffA);
            PG8_WAIT_V(8); PG8_WAIT_L(0); PG8_BAR; PG8_MMA(0, 0, At, B0); PG8_MMA(0, 1, At, B1); PG8_BAR; PG8_SCHED;
            PG8_LDA(At, 0, 1); PG8_STAGE(PG8_SB(0, 0), b2, voffB); PG8_STAGE(PG8_SB(0, 1), b2 + hstep, voffB); PG8_STAGE(PG8_SA(0, 0), a2, voffA);
            PG8_WAIT_V(8); PG8_WAIT_L(0); PG8_BAR; PG8_MMA(1, 0, At, B0); PG8_MMA(1, 1, At, B1); PG8_BAR; PG8_SCHED;
            PG8_LDB(B0, 1, 0); PG8_LDB(B1, 1, 1); PG8_SCHED; PG8_LDA(At, 1, 0); PG8_STAGE(PG8_SA(0, 1), a2 + hstep, voffA);
            PG8_WAIT_V(8); PG8_WAIT_L(0); PG8_BAR; PG8_MMA(0, 0, At, B0); PG8_MMA(0, 1, At, B1); PG8_BAR; PG8_SCHED;
            PG8_LDA(At, 1, 1); PG8_STAGE(PG8_SB(1, 0), b3, voffB); PG8_STAGE(PG8_SB(1, 1), b3 + hstep, voffB); PG8_STAGE(PG8_SA(1, 0), a3, voffA);
            PG8_WAIT_V(8); PG8_WAIT_L(0); PG8_BAR; PG8_MMA(1, 0, At, B0); PG8_MMA(1, 1, At, B1); PG8_BAR; PG8_SCHED;
            } else {
            PG8_LDB(B0, 0, 0); PG8_SCHED; PG8_LDA(At, 0, 0); PG8_STAGE(PG8_SA(1, 1), a1 + hstep, voffA);
            PG8_WAIT_L(8); PG8_BAR; PG8_WAIT_L(0); PG8_MMA(0, 0, At, B0); PG8_BAR; PG8_SCHED;
            PG8_LDB(B1, 0, 1); PG8_STAGE(PG8_SB(0, 0), b2, voffB);
            PG8_BAR; PG8_WAIT_L(0); PG8_MMA(0, 1, At, B1); PG8_BAR;
            PG8_LDA(At, 0, 1); PG8_STAGE(PG8_SA(0, 0), a2, voffA);
            PG8_BAR; PG8_WAIT_L(0); PG8_MMA(1, 0, At, B0); PG8_BAR; PG8_SCHED;
            PG8_STAGE(PG8_SB(0, 1), b2 + hstep, voffB);
            PG8_WAIT_V(6); PG8_BAR; PG8_MMA(1, 1, At, B1); PG8_BAR;
            PG8_LDB(B0, 1, 0); PG8_SCHED; PG8_LDA(At, 1, 0); PG8_STAGE(PG8_SA(0, 1), a2 + hstep, voffA);
            PG8_WAIT_L(8); PG8_BAR; PG8_WAIT_L(0); PG8_MMA(0, 0, At, B0); PG8_BAR; PG8_SCHED;
            PG8_LDB(B1, 1, 1); PG8_STAGE(PG8_SB(1, 0), b3, voffB);
            PG8_BAR; PG8_WAIT_L(0); PG8_MMA(0, 1, At, B1); PG8_BAR;
            PG8_LDA(At, 1, 1); PG8_STAGE(PG8_SA(1, 0), a3, voffA);
            PG8_BAR; PG8_WAIT_L(0); PG8_MMA(1, 0, At, B0); PG8_BAR; PG8_SCHED;
            PG8_STAGE(PG8_SB(1, 1), b3 + hstep, voffB);
            PG8_WAIT_V(6); PG8_BAR; PG8_MMA(1, 1, At, B1); PG8_BAR;
            }
        }
        if constexpr (ALIGN_EPI) { if (wr == 0) PG8_BAR; }
        if constexpr (!Epi::AFTER_DRAIN) { E(acc, cur, wr, wc, fr, fq); S.done(cur); }
        if (!has_next) break;
#pragma unroll
        for (int a = 0; a < 2; ++a)
#pragma unroll
            for (int b = 0; b < 2; ++b)
#pragma unroll
                for (int m = 0; m < 4; ++m)
#pragma unroll
                    for (int n = 0; n < 2; ++n) acc[a][b][m][n] = (f32x4){0.f, 0.f, 0.f, 0.f};
        cur = nxt; cA = nA; cB = nB; ++ui;
        if constexpr (ALIGN_EPI) { if (wr == 1) PG8_BAR; }
    }
    PG8_WAIT_V(0);
    if constexpr (!ALIGN_EPI) { if (wr == 0) PG8_BAR; }
    PG8_BAR;
    if constexpr (Epi::AFTER_DRAIN) { E.fused(acc, cur, wr, wc, fr, fq, lds, wid, lane); S.done(cur); }
#undef PG8_SA
#undef PG8_SB
#undef PG8_STAGE
#undef PG8_LDA
#undef PG8_LDB
#undef PG8_MMA
#undef PG8_WAIT_V
#undef PG8_WAIT_L
#undef PG8_BAR
#undef PG8_SCHED
}
}

namespace att {
#define LAS __attribute__((address_space(3)))
typedef unsigned short bf16;
typedef short bf16x8 __attribute__((ext_vector_type(8)));
typedef short s16x4 __attribute__((ext_vector_type(4)));
typedef float f32x16 __attribute__((ext_vector_type(16)));
typedef unsigned u32x4 __attribute__((ext_vector_type(4)));
constexpr int SEQ = 4096, PITCH = 3072;
__device__ __forceinline__ int crow(int r, int hi) { return (r & 3) + 8 * (r >> 2) + 4 * hi; }
#define SBAR() __builtin_amdgcn_sched_barrier(0)
__device__ __forceinline__ void glds16(const void* gsrc, unsigned lds_dst) { unsigned keep;
  asm volatile("s_mov_b32 %0, m0\n\ts_mov_b32 m0, %2\n\ts_nop 0\n\tglobal_load_lds_dwordx4 %1, off\n\ts_mov_b32 m0, %0" : "=&s"(keep) : "v"(gsrc), "s"(lds_dst) : "memory"); }
typedef float f32x2_t __attribute__((ext_vector_type(2))); typedef __bf16 bf16x2_t __attribute__((ext_vector_type(2)));
__device__ __forceinline__ unsigned cvtpk_s(float lo, float hi) { f32x2_t v = {lo, hi}; bf16x2_t b = __builtin_convertvector(v, bf16x2_t); return __builtin_bit_cast(unsigned, b); }
#define WAIT_BAR0() asm volatile("s_waitcnt vmcnt(0) lgkmcnt(0)\n\ts_barrier" ::: "memory")
__device__ __forceinline__ long kdma_off(int w, int lane, int pitch) { const int key = 8 * w + (lane >> 3), ch = (lane & 7) ^ ((key >> 1) & 7); return (long)key * pitch + ch * 8; }
__device__ __forceinline__ void qkt(f32x16& p0, f32x16& p1, const LAS char* Kslot, const bf16x8* qr, const f32x16& cinit, int r32, int hi) {
  const LAS char* kb = Kslot + r32 * 128; const int sw = (r32 >> 1) & 7;
#pragma unroll
  for (int d0 = 0; d0 < 4; ++d0) { const int co = ((2 * d0 + hi) ^ sw) << 4;
    const bf16x8 b0 = *(const LAS bf16x8*)(kb + co);
    const bf16x8 b1 = *(const LAS bf16x8*)(kb + co + 4096);
    if (d0 == 0) { p0 = __builtin_amdgcn_mfma_f32_32x32x16_bf16(b0, qr[0], cinit, 0, 0, 0); p1 = __builtin_amdgcn_mfma_f32_32x32x16_bf16(b1, qr[0], cinit, 0, 0, 0); }
    else { p0 = __builtin_amdgcn_mfma_f32_32x32x16_bf16(b0, qr[d0], p0, 0, 0, 0); p1 = __builtin_amdgcn_mfma_f32_32x32x16_bf16(b1, qr[d0], p1, 0, 0, 0); } }
}
__device__ __forceinline__ void pv(f32x16& oA, f32x16& oB, int vb, bf16x8 pa0, bf16x8 pa1, bf16x8 pa2, bf16x8 pa3) {
#pragma unroll
  for (int d0 = 0; d0 < 2; ++d0) { s16x4 lo[4], hi[4];
#pragma unroll
    for (int ks = 0; ks < 4; ++ks) {
      asm volatile("ds_read_b64_tr_b16 %0,%1 offset:%c2" : "=&v"(lo[ks]) : "v"(vb), "i"(d0 * 4096 + ks * 1024) : "memory");
      asm volatile("ds_read_b64_tr_b16 %0,%1 offset:%c2" : "=&v"(hi[ks]) : "v"(vb), "i"(d0 * 4096 + ks * 1024 + 512) : "memory"); }
    asm volatile("s_waitcnt lgkmcnt(0)" ::: "memory"); SBAR();
#define PK(k) (bf16x8){lo[k][0], lo[k][1], lo[k][2], lo[k][3], hi[k][0], hi[k][1], hi[k][2], hi[k][3]}
    f32x16 o = d0 ? oB : oA;
    o = __builtin_amdgcn_mfma_f32_32x32x16_bf16(pa0, PK(0), o, 0, 0, 0);
    o = __builtin_amdgcn_mfma_f32_32x32x16_bf16(pa1, PK(1), o, 0, 0, 0);
    o = __builtin_amdgcn_mfma_f32_32x32x16_bf16(pa2, PK(2), o, 0, 0, 0);
    o = __builtin_amdgcn_mfma_f32_32x32x16_bf16(pa3, PK(3), o, 0, 0, 0);
    if (d0) oB = o; else oA = o;
#undef PK
  }
}
typedef short v4i16_t __attribute__((ext_vector_type(4)));
__device__ __forceinline__ s16x4 vtr(const LAS char* p) { return __builtin_bit_cast(s16x4, __builtin_amdgcn_ds_read_tr16_b64_v4i16((LAS v4i16_t*)p)); }
__device__ __forceinline__ void pv2(f32x16& oA, f32x16& oB, const LAS char* vp, bf16x8 pa0, bf16x8 pa1, bf16x8 pa2, bf16x8 pa3) {
  s16x4 lo[8], hi[8];
#pragma unroll
  for (int i = 0; i < 8; ++i) { lo[i] = vtr(vp + (i >> 2) * 4096 + (i & 3) * 1024); hi[i] = vtr(vp + (i >> 2) * 4096 + (i & 3) * 1024 + 512); }
#define PK(k) (bf16x8){lo[k][0], lo[k][1], lo[k][2], lo[k][3], hi[k][0], hi[k][1], hi[k][2], hi[k][3]}
  oA = __builtin_amdgcn_mfma_f32_32x32x16_bf16(pa0, PK(0), oA, 0, 0, 0); oB = __builtin_amdgcn_mfma_f32_32x32x16_bf16(pa0, PK(4), oB, 0, 0, 0);
  oA = __builtin_amdgcn_mfma_f32_32x32x16_bf16(pa1, PK(1), oA, 0, 0, 0); oB = __builtin_amdgcn_mfma_f32_32x32x16_bf16(pa1, PK(5), oB, 0, 0, 0);
  oA = __builtin_amdgcn_mfma_f32_32x32x16_bf16(pa2, PK(2), oA, 0, 0, 0); oB = __builtin_amdgcn_mfma_f32_32x32x16_bf16(pa2, PK(6), oB, 0, 0, 0);
  oA = __builtin_amdgcn_mfma_f32_32x32x16_bf16(pa3, PK(3), oA, 0, 0, 0); oB = __builtin_amdgcn_mfma_f32_32x32x16_bf16(pa3, PK(7), oB, 0, 0, 0);
#undef PK
}
#define PACK_P(P0, P1) \
  const u32x4 pw0 = (u32x4){cvtpk_s(P0[0], P0[1]), cvtpk_s(P0[2], P0[3]), cvtpk_s(P0[4], P0[5]), cvtpk_s(P0[6], P0[7])}; \
  const u32x4 pw1 = (u32x4){cvtpk_s(P0[8], P0[9]), cvtpk_s(P0[10], P0[11]), cvtpk_s(P0[12], P0[13]), cvtpk_s(P0[14], P0[15])}; \
  const u32x4 pw2 = (u32x4){cvtpk_s(P1[0], P1[1]), cvtpk_s(P1[2], P1[3]), cvtpk_s(P1[4], P1[5]), cvtpk_s(P1[6], P1[7])}; \
  const u32x4 pw3 = (u32x4){cvtpk_s(P1[8], P1[9]), cvtpk_s(P1[10], P1[11]), cvtpk_s(P1[12], P1[13]), cvtpk_s(P1[14], P1[15])};
#define PAF(k) __builtin_bit_cast(bf16x8, pw##k)
__device__ __forceinline__ unsigned short f2bf1(float v) { return (unsigned short)(cvtpk_s(v, 0.f) & 0xffffu); }

constexpr float SB_STOP = -40.0f;
constexpr int SB_STAGE = 65536, SB_LDS_V = 32768, SB_LDS_FLAG = 131072;
__device__ __forceinline__ void sb_unit(int b, int hg, int c, const bf16* __restrict__ P, bf16* __restrict__ OA, char* shm) {
  int tid_l = threadIdx.x; asm volatile("" : "+v"(tid_l)); const int tid = tid_l, lane = tid & 63, r32 = lane & 31, hi = lane >> 5; const int wid = __builtin_amdgcn_readfirstlane(tid >> 6);
  const int hw = wid >> 1, h = 4 * hg + hw, half = wid & 1;
  const long rowbase = (long)b * SEQ; const int q0 = c * 64;
  const bf16* Qw = P + (rowbase + q0 + half * 32) * PITCH + h * 64;
  const bf16* Kg = P + rowbase * PITCH + 512 + hg * 256; const bf16* Vg = P + rowbase * PITCH + 1024 + hg * 256;
  const unsigned lds0 = (unsigned)(uintptr_t)shm;
  const LAS char* shm3 = (const LAS char*)shm;
  volatile LAS unsigned* flags = (volatile LAS unsigned*)(shm3 + SB_LDS_FLAG);
  const bf16* ksrc = Kg + kdma_off(wid, lane, PITCH);
  const bf16* vsrc = Vg + (long)(16 * (wid & 3) + (lane >> 2)) * PITCH + (wid >> 2) * 32 + (lane & 3) * 8;
  const unsigned pdst = lds0 + wid * 1024;
  const LAS char* kp0 = shm3 + hw * 8192;
  const LAS char* vp0 = shm3 + SB_LDS_V + hw * 8192 + ((lane >> 4) & 1) * 32 + (lane & 3) * 8 + (4 * hi + ((lane & 15) >> 2)) * 64;
#define SB_DMA(t, st) do { const long go_ = (long)(t) * 64 * PITCH; const unsigned d_ = (unsigned)__builtin_amdgcn_readfirstlane(pdst + (st) * SB_STAGE); \
    _Pragma("unroll") for (int hh = 0; hh < 4; ++hh) { glds16(ksrc + go_ + hh * 64, d_ + hh * 8192); glds16(vsrc + go_ + hh * 64, d_ + SB_LDS_V + hh * 8192); } } while (0)
  SB_DMA(c, 0);
  bf16x8 qr[4];
#pragma unroll
  for (int d0 = 0; d0 < 4; ++d0) qr[d0] = *(const bf16x8*)(Qw + (long)r32 * PITCH + d0 * 16 + hi * 8);
  f32x16 oA = f32x16{}, oB = f32x16{}; const f32x16 zero = f32x16{};
  float carry = 0.f;
  const int qrow = half * 32 + r32;
  int cur = 0;
  for (int t = c; t >= 0; --t) {
    WAIT_BAR0();
    if (t != c) { const unsigned f = flags[(cur ^ 1) * 8 + (lane & 7)]; if (__all(f != 0u)) break; }
    if (t > 0) SB_DMA(t - 1, cur ^ 1);
    {
      f32x16 p0, p1, l0, l1;
      qkt(p0, p1, kp0 + cur * SB_STAGE, qr, zero, r32, hi);
      const bool diag = (t == c); const int kvb = 4 * hi;
#pragma unroll
      for (int r = 0; r < 16; ++r) {
        { const float x = p0[r], e = __builtin_amdgcn_exp2f(-__builtin_fabsf(x)), sp = __builtin_fmaxf(x, 0.f) + __builtin_amdgcn_logf(1.0f + e);
          float l = -sp, zl = x - sp; if (diag) { const bool ok = (kvb + (r & 3) + 8 * (r >> 2)) < qrow; l = ok ? l : 0.f; zl = ok ? zl : -INFINITY; } l0[r] = l; p0[r] = zl; }
        { const float x = p1[r], e = __builtin_amdgcn_exp2f(-__builtin_fabsf(x)), sp = __builtin_fmaxf(x, 0.f) + __builtin_amdgcn_logf(1.0f + e);
          float l = -sp, zl = x - sp; if (diag) { const bool ok = (kvb + 32 + (r & 3) + 8 * (r >> 2)) < qrow; l = ok ? l : 0.f; zl = ok ? zl : -INFINITY; } l1[r] = l; p1[r] = zl; }
      }
      float gs[8], ps[8];
#pragma unroll
      for (int g = 0; g < 4; ++g) { gs[g] = (l0[4 * g] + l0[4 * g + 1]) + (l0[4 * g + 2] + l0[4 * g + 3]); gs[4 + g] = (l1[4 * g] + l1[4 * g + 1]) + (l1[4 * g + 2] + l1[4 * g + 3]); }
#pragma unroll
      for (int g = 0; g < 8; ++g) ps[g] = __shfl_xor(gs[g], 32);
      float R = carry;
#pragma unroll
      for (int gi = 7; gi >= 0; --gi) {
        float E = R + (hi == 0 ? ps[gi] : 0.f);
        R += gs[gi] + ps[gi];
        const int g = gi & 3;
        if (gi >= 4) { p1[4 * g + 3] = __builtin_amdgcn_exp2f(p1[4 * g + 3] + E); E += l1[4 * g + 3]; p1[4 * g + 2] = __builtin_amdgcn_exp2f(p1[4 * g + 2] + E); E += l1[4 * g + 2];
                       p1[4 * g + 1] = __builtin_amdgcn_exp2f(p1[4 * g + 1] + E); E += l1[4 * g + 1]; p1[4 * g] = __builtin_amdgcn_exp2f(p1[4 * g] + E); }
        else         { p0[4 * g + 3] = __builtin_amdgcn_exp2f(p0[4 * g + 3] + E); E += l0[4 * g + 3]; p0[4 * g + 2] = __builtin_amdgcn_exp2f(p0[4 * g + 2] + E); E += l0[4 * g + 2];
                       p0[4 * g + 1] = __builtin_amdgcn_exp2f(p0[4 * g + 1] + E); E += l0[4 * g + 1]; p0[4 * g] = __builtin_amdgcn_exp2f(p0[4 * g] + E); }
      }
      carry = R;
      PACK_P(p0, p1)
      pv2(oA, oB, vp0 + cur * SB_STAGE, PAF(0), PAF(1), PAF(2), PAF(3));
    }
    if (lane == 0) flags[cur * 8 + wid] = __any(carry > SB_STOP) ? 0u : 1u;
    cur ^= 1;
  }
#undef SB_DMA
  WAIT_BAR0();
  bf16* Ow = OA + (rowbase + q0 + half * 32) * 1024 + h * 64;
#pragma unroll
  for (int r = 0; r < 16; ++r) { const int orow = crow(r, hi); Ow[(long)orow * 1024 + r32] = f2bf1(oA[r]); Ow[(long)orow * 1024 + 32 + r32] = f2bf1(oB[r]); }
}

constexpr int DA_VBASE = 32768, DA_WS = 81920;
__device__ __forceinline__ void da_issue_first(int b, int h, const bf16* __restrict__ P, char* shm) {
  int tid_l = threadIdx.x; asm volatile("" : "+v"(tid_l)); const int lane = tid_l & 63; const int wid = __builtin_amdgcn_readfirstlane(tid_l >> 6);
  const long rowbase = (long)b * SEQ;
  const bf16* Kh = P + rowbase * PITCH + 2048 + h * 128; const bf16* Vh = P + rowbase * PITCH + 2560 + h * 128;
  const bf16* ksrc = Kh + kdma_off(wid, lane, PITCH);
  const bf16* vsrc = Vh + (long)(16 * (wid & 3) + (lane >> 2)) * PITCH + (wid >> 2) * 32 + (lane & 3) * 8;
  const unsigned pdst = (unsigned)(uintptr_t)shm + wid * 1024;
  const unsigned d0 = (unsigned)__builtin_amdgcn_readfirstlane(pdst), d1 = (unsigned)__builtin_amdgcn_readfirstlane(pdst + 32768), d2 = (unsigned)__builtin_amdgcn_readfirstlane(pdst + 16384);
  glds16(ksrc, d0); glds16(ksrc + 64, d0 + 8192);
  glds16(vsrc, d1); glds16(vsrc + 64, d1 + 8192);
  glds16(ksrc + (long)64 * PITCH, d2); glds16(ksrc + (long)64 * PITCH + 64, d2 + 8192);
}
template <bool PRE>
__device__ __forceinline__ void da_unit(int b, int h, int qb, const bf16* __restrict__ P, bf16* __restrict__ OB, char* shm, float lam, const float* __restrict__ gsub) {
  int tid_l = threadIdx.x; asm volatile("" : "+v"(tid_l)); const int tid = tid_l, lane = tid & 63, r32 = lane & 31, hi = lane >> 5; const int wid = __builtin_amdgcn_readfirstlane(tid >> 6);
  const int comp = wid >> 2, wq = wid & 3;
  const long rowbase = (long)b * SEQ; const int q0 = qb * 128;
  const bf16* Qw = P + (rowbase + q0 + wq * 32) * PITCH + 1536 + h * 128 + comp * 64;
  const bf16* Kh = P + rowbase * PITCH + 2048 + h * 128; const bf16* Vh = P + rowbase * PITCH + 2560 + h * 128;
  const unsigned lds0 = (unsigned)(uintptr_t)shm;
  const LAS char* shm3 = (const LAS char*)shm;
  LAS float* wsf = (LAS float*)(shm3 + DA_WS) + wid * 64;
  const bf16* ksrc = Kh + kdma_off(wid, lane, PITCH);
  const bf16* vsrc = Vh + (long)(16 * (wid & 3) + (lane >> 2)) * PITCH + (wid >> 2) * 32 + (lane & 3) * 8;
  const unsigned pdst = lds0 + wid * 1024;
  const LAS char* vp0 = shm3 + ((lane >> 4) & 1) * 32 + (lane & 3) * 8 + (4 * hi + ((lane & 15) >> 2)) * 64;
  const int NT = 2 * qb + 2, my_last = 2 * qb + (wq >> 1);
#define DA_DMA_K(t, sl) do { const long go_ = (long)(t) * 64 * PITCH; const unsigned d_ = (unsigned)__builtin_amdgcn_readfirstlane(pdst + (sl) * 16384); glds16(ksrc + go_, d_); glds16(ksrc + go_ + 64, d_ + 8192); } while (0)
#define DA_DMA_V(t, sl) do { const long go_ = (long)(t) * 64 * PITCH; const unsigned d_ = (unsigned)__builtin_amdgcn_readfirstlane(pdst + DA_VBASE + (sl) * 16384); glds16(vsrc + go_, d_); glds16(vsrc + go_ + 64, d_ + 8192); } while (0)
  if (!PRE) { DA_DMA_K(0, 0); DA_DMA_V(0, 0); DA_DMA_K(1, 1); }
  bf16x8 qr[4];
#pragma unroll
  for (int d0 = 0; d0 < 4; ++d0) qr[d0] = *(const bf16x8*)(Qw + (long)r32 * PITCH + d0 * 16 + hi * 8);
  f32x16 o0 = f32x16{}, o1 = f32x16{}, o2 = f32x16{}, o3 = f32x16{}; const f32x16 zero = f32x16{};
  float lsum = 0.f;
  WAIT_BAR0();
  const int ksw = ((r32 >> 1) & 7) ^ hi;
#define kco_(d0) ((((2 * (d0))) ^ ksw) << 4)
  f32x16 sc0, sc1;
  qkt(sc0, sc1, shm3 + comp * 8192, qr, zero, r32, hi);
  u32x4 pw0 = {0u, 0u, 0u, 0u}, pw1 = pw0, pw2 = pw0, pw3 = pw0;
#define DA_PK(L, H, k) (bf16x8){L[k][0], L[k][1], L[k][2], L[k][3], H[k][0], H[k][1], H[k][2], H[k][3]}
#define DA_PVMM(VP) do { const LAS char* vq_ = (VP); s16x4 lo_[8], hi_[8], lo2_[8], hi2_[8]; \
      _Pragma("unroll") for (int i = 0; i < 8; ++i) { lo_[i] = vtr(vq_ + (i >> 2) * 4096 + (i & 3) * 1024); hi_[i] = vtr(vq_ + (i >> 2) * 4096 + (i & 3) * 1024 + 512); } \
      SBAR(); \
      _Pragma("unroll") for (int k = 0; k < 4; ++k) { const bf16x8 pa_ = (k == 0) ? PAF(0) : (k == 1) ? PAF(1) : (k == 2) ? PAF(2) : PAF(3); \
        o0 = __builtin_amdgcn_mfma_f32_32x32x16_bf16(pa_, DA_PK(lo_, hi_, k), o0, 0, 0, 0); o1 = __builtin_amdgcn_mfma_f32_32x32x16_bf16(pa_, DA_PK(lo_, hi_, k + 4), o1, 0, 0, 0); } \
      _Pragma("unroll") for (int i = 0; i < 8; ++i) { lo2_[i] = vtr(vq_ + 8192 + (i >> 2) * 4096 + (i & 3) * 1024); hi2_[i] = vtr(vq_ + 8192 + (i >> 2) * 4096 + (i & 3) * 1024 + 512); } \
      SBAR(); \
      _Pragma("unroll") for (int k = 0; k < 4; ++k) { const bf16x8 pa_ = (k == 0) ? PAF(0) : (k == 1) ? PAF(1) : (k == 2) ? PAF(2) : PAF(3); \
        o2 = __builtin_amdgcn_mfma_f32_32x32x16_bf16(pa_, DA_PK(lo2_, hi2_, k), o2, 0, 0, 0); o3 = __builtin_amdgcn_mfma_f32_32x32x16_bf16(pa_, DA_PK(lo2_, hi2_, k + 4), o3, 0, 0, 0); } \
      SBAR(); } while (0)
#define DA_STEP(T, ACT, ACTN, PVP, VAR) do { \
    WAIT_BAR0(); \
    const int v0_ = vs0, v1_ = (vs0 == 2) ? 0 : vs0 + 1, vm_ = (v1_ == 2) ? 0 : v1_ + 1; vs0 = v1_; \
    if ((T) + 2 < NT) DA_DMA_K((T) + 2, (T) & 1); \
    if ((T) + 1 < NT) DA_DMA_V((T) + 1, v1_); \
    if (VAR == 1) { if (PVP) DA_PVMM(vp0 + DA_VBASE + vm_ * 16384); } \
    const LAS char* kb_ = shm3 + (((T) + 1) & 1) * 16384 + comp * 8192 + r32 * 128; \
    bf16x8 kf_[4]; f32x16 sn0_ = sc0, sn1_ = sc1; \
    if (ACTN) { _Pragma("unroll") for (int d0 = 0; d0 < 2; ++d0) { kf_[2 * d0] = *(const LAS bf16x8*)(kb_ + kco_(d0)); kf_[2 * d0 + 1] = *(const LAS bf16x8*)(kb_ + kco_(d0) + 4096); } } \
    SBAR(); \
    if (ACTN) { sn0_ = __builtin_amdgcn_mfma_f32_32x32x16_bf16(kf_[0], qr[0], zero, 0, 0, 0); sn1_ = __builtin_amdgcn_mfma_f32_32x32x16_bf16(kf_[1], qr[0], zero, 0, 0, 0); \
      sn0_ = __builtin_amdgcn_mfma_f32_32x32x16_bf16(kf_[2], qr[1], sn0_, 0, 0, 0); sn1_ = __builtin_amdgcn_mfma_f32_32x32x16_bf16(kf_[3], qr[1], sn1_, 0, 0, 0); \
      _Pragma("unroll") for (int d0 = 2; d0 < 4; ++d0) { kf_[2 * d0 - 4] = *(const LAS bf16x8*)(kb_ + kco_(d0)); kf_[2 * d0 - 3] = *(const LAS bf16x8*)(kb_ + kco_(d0) + 4096); } \
      sn0_ = __builtin_amdgcn_mfma_f32_32x32x16_bf16(kf_[0], qr[2], sn0_, 0, 0, 0); sn1_ = __builtin_amdgcn_mfma_f32_32x32x16_bf16(kf_[1], qr[2], sn1_, 0, 0, 0); \
      sn0_ = __builtin_amdgcn_mfma_f32_32x32x16_bf16(kf_[2], qr[3], sn0_, 0, 0, 0); sn1_ = __builtin_amdgcn_mfma_f32_32x32x16_bf16(kf_[3], qr[3], sn1_, 0, 0, 0); } \
    if (ACT) { \
      float e0_ = 0.f, e1_ = 0.f; \
      _Pragma("unroll") for (int r = 0; r < 16; ++r) { sc0[r] = __builtin_amdgcn_exp2f(sc0[r]); sc1[r] = __builtin_amdgcn_exp2f(sc1[r]); e0_ += sc0[r]; e1_ += sc1[r]; } \
      lsum += e0_ + e1_; \
      pw0 = (u32x4){cvtpk_s(sc0[0], sc0[1]), cvtpk_s(sc0[2], sc0[3]), cvtpk_s(sc0[4], sc0[5]), cvtpk_s(sc0[6], sc0[7])}; \
      pw1 = (u32x4){cvtpk_s(sc0[8], sc0[9]), cvtpk_s(sc0[10], sc0[11]), cvtpk_s(sc0[12], sc0[13]), cvtpk_s(sc0[14], sc0[15])}; \
      pw2 = (u32x4){cvtpk_s(sc1[0], sc1[1]), cvtpk_s(sc1[2], sc1[3]), cvtpk_s(sc1[4], sc1[5]), cvtpk_s(sc1[6], sc1[7])}; \
      pw3 = (u32x4){cvtpk_s(sc1[8], sc1[9]), cvtpk_s(sc1[10], sc1[11]), cvtpk_s(sc1[12], sc1[13]), cvtpk_s(sc1[14], sc1[15])}; \
      _Pragma("unroll") for (int i = 0; i < 8; ++i) { __builtin_amdgcn_sched_group_barrier(0x008, 1, 0); __builtin_amdgcn_sched_group_barrier(0x002, 10, 0); } \
    } \
    SBAR(); \
    if (VAR == 0) { if (ACT) DA_PVMM(vp0 + DA_VBASE + v0_ * 16384); } \
    sc0 = sn0_; sc1 = sn1_; \
  } while (0)
  int t = 0, vs0 = 0;
  if (comp == 0) {
#pragma unroll 1
    for (; t + 2 < NT; ++t) DA_STEP(t, true, true, false, 0);
#pragma unroll 1
    for (; t < NT; ++t) DA_STEP(t, (t <= my_last), (t + 1 <= my_last), false, 0);
  } else {
#pragma unroll 1
    for (; t + 2 < NT; ++t) DA_STEP(t, true, true, (t >= 1), 1);
#pragma unroll 1
    for (; t < NT; ++t) DA_STEP(t, (t <= my_last), (t + 1 <= my_last), (t >= 1 && t - 1 <= my_last), 1);
    if (NT - 1 <= my_last) DA_PVMM(vp0 + DA_VBASE + (((NT - 1) % 3) * 16384));
  }
#undef DA_STEP
#undef DA_PVMM
#undef DA_PK
#undef DA_DMA_K
#undef DA_DMA_V
  lsum += __shfl_xor(lsum, 32);
  if (hi == 0) wsf[r32] = lsum;
  WAIT_BAR0();
  float rl[16];
#pragma unroll
  for (int r = 0; r < 16; ++r) rl[r] = __builtin_amdgcn_rcpf(wsf[crow(r, hi)]) * (comp ? lam : 1.0f);
#pragma unroll
  for (int r = 0; r < 16; ++r) { o0[r] *= rl[r]; o1[r] *= rl[r]; o2[r] *= rl[r]; o3[r] *= rl[r]; }
  LAS float* X = (LAS float*)shm3;
  if (comp == 1) {
#pragma unroll
    for (int r = 0; r < 16; ++r) { LAS float* xr = X + (wq * 32 + crow(r, hi)) * 128 + r32; xr[0] = o0[r]; xr[32] = o1[r]; xr[64] = o2[r]; xr[96] = o3[r]; }
  }
  WAIT_BAR0();
  if (comp == 0) {
    const float g0 = gsub[r32] * 0.8f, g1 = gsub[32 + r32] * 0.8f, g2 = gsub[64 + r32] * 0.8f, g3 = gsub[96 + r32] * 0.8f;
    bf16* Ow = OB + (rowbase + q0 + wq * 32) * 1024 + 512 + h * 128;
#pragma unroll
    for (int r = 0; r < 16; ++r) { const LAS float* xr = X + (wq * 32 + crow(r, hi)) * 128 + r32;
      const float a0 = o0[r] - xr[0], a1 = o1[r] - xr[32], a2 = o2[r] - xr[64], a3 = o3[r] - xr[96];
      float ss = (a0 * a0 + a1 * a1) + (a2 * a2 + a3 * a3);
      ss += __shfl_xor(ss, 1); ss += __shfl_xor(ss, 2); ss += __shfl_xor(ss, 4); ss += __shfl_xor(ss, 8); ss += __shfl_xor(ss, 16);
      const float rstd = __builtin_amdgcn_rsqf(ss * (1.0f / 128.0f) + 1e-6f);
      bf16* op = Ow + (long)crow(r, hi) * 1024 + r32;
      op[0] = f2bf1(a0 * rstd * g0); op[32] = f2bf1(a1 * rstd * g1); op[64] = f2bf1(a2 * rstd * g2); op[96] = f2bf1(a3 * rstd * g3); }
  }
  WAIT_BAR0();
}
#undef SBAR
}

namespace cg = cooperative_groups;
constexpr int NWAVES = 8;
constexpr int BATCH = 4, SEQ = 4096, D = 1024, M = BATCH * SEQ, FF = 2816, NPG = 5120  , NGU = 2 * FF;
constexpr size_t MiB = 1u << 20;
constexpr size_t WS_SSQ = 1 * MiB, WS_ROPE = 2 * MiB, WS_W1 = 4 * MiB, WS_WAB = 14 * MiB, WS_WOUT = 16 * MiB, WS_WGU = 18 * MiB, WS_WD = 29 * MiB;
constexpr size_t WS_XN = 36 * MiB, WS_PROJ = 68 * MiB, WS_MERGED = 156 * MiB, WS_FF = 68 * MiB, WS_GATES = 192 * MiB, WS_END = 256 * MiB;
constexpr int LDS_BYTES = 147456;

typedef unsigned short bf16;
typedef unsigned v4u __attribute__((ext_vector_type(4)));
typedef float f32x4 __attribute__((ext_vector_type(4)));
#define LDS_WAIT() asm volatile("s_waitcnt lgkmcnt(0)" ::: "memory")
__device__ __forceinline__ unsigned pk2(float lo, float hi) { return pg8::cvt_pk_bf16(lo, hi); }
__device__ __forceinline__ float wave_sum(float v) {
#pragma unroll
    for (int o = 1; o < 64; o <<= 1) v += __shfl_xor(v, o);
    return v;
}
__device__ __forceinline__ float wave_max(float v) {
#pragma unroll
    for (int o = 1; o < 64; o <<= 1) v = __builtin_fmaxf(v, __shfl_xor(v, o));
    return v;
}
__device__ __forceinline__ void tr_item64(const float* __restrict__ W, int srcN, int colA, int colB, int k0, bf16* __restrict__ WT, int K, int dstrow0, const float* __restrict__ gk, LAS float* scr, int lane) {
    const int n4 = (lane & 15) * 4, kq = lane >> 4;
    const int scol = (n4 < 32 ? colA : colB) + (n4 & 31);
    f32x4 v[16];
#pragma unroll
    for (int i = 0; i < 16; ++i) v[i] = *(const f32x4*)(W + (size_t)(k0 + 4 * i + kq) * srcN + scol);
#pragma unroll
    for (int i = 0; i < 16; ++i) { f32x4 w = v[i]; if (gk) w = w * gk[k0 + 4 * i + kq]; *(LAS f32x4*)(scr + (4 * i + kq) * 68 + n4) = w; }
    LDS_WAIT(); asm volatile("" ::: "memory");
    const int c = lane & 7;
#pragma unroll
    for (int j = 0; j < 8; ++j) { const int n = (lane >> 3) + 8 * j; const LAS float* sp = scr + (8 * c) * 68 + n;
        v4u o; o.x = pk2(sp[0], sp[68]); o.y = pk2(sp[2 * 68], sp[3 * 68]); o.z = pk2(sp[4 * 68], sp[5 * 68]); o.w = pk2(sp[6 * 68], sp[7 * 68]);
        *(v4u*)(WT + (size_t)(dstrow0 + n) * K + k0 + 8 * c) = o; }
    LDS_WAIT(); asm volatile("" ::: "memory");
}

#define XB_TMO      128
#define XB_XCNT(j)  (256  + 64 * (j))
#define XB_XSUB(j)  (1280 + 64 * (j))
#define XB_XGEN(j)  (2304 + 64 * (j))
#define XB_TOP      3328
#define XB_TOPGEN   3392
#define XCD_BAR_WORDS 3456
#define XB_SPIN_CAP (1u << 18)

__device__ __forceinline__ unsigned xb_ld(unsigned* p)              { return __hip_atomic_load(p, __ATOMIC_RELAXED, __HIP_MEMORY_SCOPE_AGENT); }
__device__ __forceinline__ unsigned xb_add(unsigned* p, unsigned v) { return __hip_atomic_fetch_add(p, v, __ATOMIC_RELAXED, __HIP_MEMORY_SCOPE_AGENT); }
__device__ __forceinline__ unsigned xb_xcc_id() { return (unsigned)__builtin_amdgcn_s_getreg((3 << 11) | 20) & 0xFu; }
#define XB_SPIN(cond, bar) do { unsigned _sp = 0; while (cond) { __builtin_amdgcn_s_sleep(1); \
    if ((++_sp & 255u) == 0u) { if (xb_ld(&(bar)[XB_TMO])) break; if (_sp > XB_SPIN_CAP) { atomicAdd(&(bar)[XB_TMO], 1u); break; } } } } while (0)

struct XcdBarrier {
    unsigned* bar; unsigned x;
    volatile LAS unsigned* st;
};

__device__ __forceinline__ XcdBarrier xcd_barrier_post(unsigned* bar, volatile LAS unsigned* st) {
    XcdBarrier b; b.bar = bar; b.x = xb_xcc_id(); b.st = st;
    if (threadIdx.x == 0) (void)xb_add(&bar[XB_XCNT(b.x)], 1u);
    return b;
}
__device__ __forceinline__ void xcd_barrier_complete(unsigned* bar, unsigned x, unsigned& nloc, unsigned& nx) {
    const unsigned G = gridDim.x * gridDim.y * gridDim.z;
    unsigned sum, cnt, mine, sp = 0u;
    for (;;) {
        sum = 0u; cnt = 0u; mine = 0u;
#pragma unroll
        for (unsigned j = 0; j < 16; ++j) { const unsigned c = xb_ld(&bar[XB_XCNT(j)]); sum += c; cnt += (c > 0u) ? 1u : 0u; mine = (j == x) ? c : mine; }
        if (sum == G) break;
        __builtin_amdgcn_s_sleep(1);
        if ((++sp & 255u) == 0u) { if (xb_ld(&bar[XB_TMO])) break; if (sp > XB_SPIN_CAP) { atomicAdd(&bar[XB_TMO], 1u); break; } }
    }
    nloc = mine > 0u ? mine : 1u; nx = cnt > 0u ? cnt : 1u;
}

__device__ __forceinline__ void xcd_barrier(const XcdBarrier& b) {
    asm volatile("s_waitcnt vmcnt(0)" ::: "memory");
    __syncthreads();
    if (threadIdx.x == 0) {
        unsigned* bar = b.bar;
        __builtin_amdgcn_s_waitcnt(0);
        unsigned nloc = b.st[0], nx = b.st[1];
        if (nloc == 0u) { xcd_barrier_complete(bar, b.x, nloc, nx); b.st[0] = nloc; b.st[1] = nx; }
        const unsigned old = xb_add(&bar[XB_XSUB(b.x)], 1u);
        const unsigned gen = old / nloc;
        if (old + 1u == (gen + 1u) * nloc) {
            __builtin_amdgcn_fence(__ATOMIC_RELEASE, "agent");
            asm volatile("s_waitcnt vmcnt(0)" ::: "memory");
            const unsigned og = xb_add(&bar[XB_TOP], 1u);
            const unsigned tg = og / nx;
            if (og + 1u == (tg + 1u) * nx) xb_add(&bar[XB_TOPGEN], 1u);
            else XB_SPIN(xb_ld(&bar[XB_TOPGEN]) == tg, bar);
            __builtin_amdgcn_fence(__ATOMIC_ACQUIRE, "agent");
            xb_add(&bar[XB_XGEN(b.x)], 1u);
            asm volatile("s_waitcnt vmcnt(0)" ::: "memory");
        } else {
            XB_SPIN(xb_ld(&bar[XB_XGEN(b.x)]) == gen, bar);
            __builtin_amdgcn_fence(__ATOMIC_ACQUIRE, "agent");
            asm volatile("s_waitcnt vmcnt(0)" ::: "memory");
        }
    }
    __syncthreads();
}

__device__ __forceinline__ void trc_load(const float* __restrict__ W, int srcN, int col, int k0h, f32x4 (&v)[8], int lane) {
    const int n4 = (lane & 15) * 4, kq = lane >> 4;
#pragma unroll
    for (int i = 0; i < 8; ++i) v[i] = *(const f32x4*)(W + (size_t)(k0h + 4 * i + kq) * srcN + col + n4);
}
__device__ __forceinline__ void trc_proc(const f32x4 (&v)[8], int h, int k0, bf16* __restrict__ WT, int K, int d0, const float* __restrict__ gk, LAS float* scr, int lane) {
    const int n4 = (lane & 15) * 4, kq = lane >> 4;
#pragma unroll
    for (int i = 0; i < 8; ++i) { const int row = 4 * i + kq; f32x4 w = v[i]; if (gk) w = w * gk[k0 + 32 * h + row]; *(LAS f32x4*)(scr + row * 68 + n4) = w; }
    LDS_WAIT(); asm volatile("" ::: "memory");
    const int cl = lane & 3, c = 4 * h + cl;
#pragma unroll
    for (int j = 0; j < 4; ++j) { const int n = (lane >> 2) + 16 * j; const LAS float* sp = scr + (8 * cl) * 68 + n;
        v4u o; o.x = pk2(sp[0], sp[68]); o.y = pk2(sp[2 * 68], sp[3 * 68]); o.z = pk2(sp[4 * 68], sp[5 * 68]); o.w = pk2(sp[6 * 68], sp[7 * 68]);
        *(v4u*)(WT + (size_t)(d0 + n) * K + k0 + 8 * c) = o; }
    LDS_WAIT(); asm volatile("" ::: "memory");
}
__device__ __forceinline__ void own_grid_barrier(unsigned* bar, unsigned target, bool wb = true) {
    asm volatile("s_waitcnt vmcnt(0) lgkmcnt(0)" ::: "memory");
    __syncthreads();
    if (threadIdx.x == 0) {
        if (wb) { __builtin_amdgcn_fence(__ATOMIC_RELEASE, "agent"); asm volatile("s_waitcnt vmcnt(0)" ::: "memory"); }
        (void)__hip_atomic_fetch_add(bar, 1u, __ATOMIC_RELAXED, __HIP_MEMORY_SCOPE_AGENT);
        unsigned spins = 0u;
        while (__hip_atomic_load(bar, __ATOMIC_RELAXED, __HIP_MEMORY_SCOPE_AGENT) < target) { __builtin_amdgcn_s_sleep(2); if (++spins > (1u << 24)) break; }
        __builtin_amdgcn_fence(__ATOMIC_ACQUIRE, "agent");
        asm volatile("s_waitcnt vmcnt(0)" ::: "memory");
    }
    __syncthreads();
}

struct Args { const float* in[19]; float* out; unsigned char* ws; };

__global__ void __launch_bounds__(NWAVES * 64, 2) mk_fwd(Args args) {
    extern __shared__ __attribute__((aligned(16))) unsigned char lds[];
    cg::grid_group grid = cg::this_grid();
    LAS unsigned char* ldsl = (LAS unsigned char*)lds;
#define PHASE_TID() int tid_l = threadIdx.x; asm volatile("" : "+v"(tid_l)); const int tid = tid_l, lane = tid & 63, wave = __builtin_amdgcn_readfirstlane(tid >> 6); (void)tid; (void)lane; (void)wave
    const int G = gridDim.x, bx = blockIdx.x, vcu = (G % 8 == 0) ? (bx % 8) * (G / 8) + bx / 8 : bx;
#define GRID_SYNC() do { xcd_barrier(xbar); } while (0)
    unsigned grp_gen = 0u;
    volatile LAS unsigned* xb_st = (volatile LAS unsigned*)(ldsl + LDS_BYTES - 16);
    if (threadIdx.x < 2) xb_st[threadIdx.x] = 0u;
    __syncthreads();
    const XcdBarrier xbar = xcd_barrier_post((unsigned*)args.ws + 4224, xb_st);
#define GROUP_SYNC() do { if (gridDim.x == 256) { ++grp_gen; own_grid_barrier((unsigned*)args.ws + 64 * (1 + (blockIdx.x & 63)), grp_gen * 4u, !grp_same); } else GRID_SYNC(); } while (0)
    unsigned* xcc_tab = (unsigned*)args.ws + 8192;
    const unsigned my_xcc = (unsigned)__builtin_amdgcn_s_getreg((3 << 11) | 20) & 0xFu;
    if (threadIdx.x == 0) __hip_atomic_store(xcc_tab + blockIdx.x, my_xcc, __ATOMIC_RELAXED, __HIP_MEMORY_SCOPE_AGENT);
    bool grp_same = false;
    if (args.ws == nullptr) grid.sync();
    typedef const __attribute__((address_space(4))) Args* KArgs;
    const KArgs kp0 = (KArgs)__builtin_amdgcn_kernarg_segment_ptr();
#define PHASE_ARGS() KArgs kp = kp0; asm volatile("" : "+s"(kp)); unsigned char* ws = kp->ws; (void)ws
    {
        PHASE_ARGS(); PHASE_TID();
        const float* x = kp->in[0]; const float* g_mix = kp->in[1]; const float* w_in = kp->in[2]; const float* w_gate = kp->in[12];
        float* ROPE = (float*)(ws + WS_ROPE); bf16* W1t = (bf16*)(ws + WS_W1); bf16* XN = (bf16*)(ws + WS_XN);
        LAS float* scr = (LAS float*)(ldsl + wave * 18432);
        const int gw = vcu * NWAVES + wave, NGW = G * NWAVES;
        constexpr int I_W1 = 16 * (NPG / 64);
        for (int r = gw; r < I_W1; r += NGW) {
            const int nb = NPG / 64, k0 = 64 * (r / nb), d0 = 64 * (r % nb), tile = d0 >> 8, p = d0 & 255, cA = tile * 256 + 64 * ((p >> 5) & 3) + 32 * (p >> 7), cB = cA + 64;
            if (tile < 12) tr_item64(w_in, 3072, cA, cB, k0, W1t, 1024, d0, nullptr, scr, lane);
            else { const int gcol = (p >> 7) * 1024 + (tile - 12) * 128 + (p & 127); tr_item64(w_gate, 2048, gcol, gcol + 32, k0, W1t, 1024, d0, nullptr, scr, lane); }
        }
        for (int m0 = gw; m0 < M; m0 += 2 * NGW) {
            const int m1 = (m0 + NGW < M) ? m0 + NGW : m0;
            const f32x4* xr0 = (const f32x4*)(x + (size_t)m0 * D) + lane; const f32x4* xr1 = (const f32x4*)(x + (size_t)m1 * D) + lane; const f32x4* gr = (const f32x4*)g_mix + lane;
            f32x4 v0[4], v1[4]; float s0 = 0.f, s1 = 0.f;
#pragma unroll
            for (int j = 0; j < 4; ++j) { v0[j] = xr0[64 * j]; v1[j] = xr1[64 * j]; }
#pragma unroll
            for (int j = 0; j < 4; ++j) { s0 += (v0[j].x * v0[j].x + v0[j].y * v0[j].y) + (v0[j].z * v0[j].z + v0[j].w * v0[j].w); s1 += (v1[j].x * v1[j].x + v1[j].y * v1[j].y) + (v1[j].z * v1[j].z + v1[j].w * v1[j].w); }
            const float r0 = __builtin_amdgcn_rsqf(wave_sum(s0) * (1.f / D) + 1e-6f), r1 = __builtin_amdgcn_rsqf(wave_sum(s1) * (1.f / D) + 1e-6f);
            unsigned long long* o0 = (unsigned long long*)(XN + (size_t)m0 * D) + lane; unsigned long long* o1 = (unsigned long long*)(XN + (size_t)m1 * D) + lane;
#pragma unroll
            for (int j = 0; j < 4; ++j) { const f32x4 g = gr[64 * j];
                o0[64 * j] = (unsigned long long)pk2(v0[j].x * r0 * g.x, v0[j].y * r0 * g.y) | ((unsigned long long)pk2(v0[j].z * r0 * g.z, v0[j].w * r0 * g.w) << 32);
                o1[64 * j] = (unsigned long long)pk2(v1[j].x * r1 * g.x, v1[j].y * r1 * g.y) | ((unsigned long long)pk2(v1[j].z * r1 * g.z, v1[j].w * r1 * g.w) << 32); }
        }
        for (int i = (vcu * NWAVES + wave) * 64 + lane; i < SEQ * 8; i += G * NWAVES * 64) {
            const int pos = i >> 3, idx = i & 7;
            const float invf = __builtin_amdgcn_exp2f(-2.3664460711655217f * (float)idx); const float ang = (float)pos * invf;
            const double rev = (double)ang * 0.15915494309189535; const float fr = (float)(rev - __builtin_floor(rev));
            ROPE[2 * i] = __builtin_amdgcn_cosf(fr); ROPE[2 * i + 1] = __builtin_amdgcn_sinf(fr);
        }
    }
    GRID_SYNC();
    if (gridDim.x == 256) { const unsigned g_ = blockIdx.x & 63; unsigned eq_ = 1u;
        for (int k = 0; k < 4; ++k) eq_ &= (__hip_atomic_load(xcc_tab + g_ + 64 * k, __ATOMIC_RELAXED, __HIP_MEMORY_SCOPE_AGENT) == my_xcc) ? 1u : 0u;
        grp_same = __builtin_amdgcn_readfirstlane(eq_) != 0u; }

    {
        PHASE_ARGS(); PHASE_TID();
        const float* g_q = kp->in[3]; const float* g_k = kp->in[4]; const float* b_gate = kp->in[13];
        float* ROPE = (float*)(ws + WS_ROPE); bf16* W1t = (bf16*)(ws + WS_W1); bf16* XN = (bf16*)(ws + WS_XN); bf16* PROJ = (bf16*)(ws + WS_PROJ); bf16* GATES = (bf16*)(ws + WS_GATES);
        pg8::Gemm g{XN, W1t, M, NPG, D}; pg8::StaticOrder S; S.init(M, NPG, G, bx);
        pg8::EpiProj E{PROJ, GATES, b_gate, g_q, g_k, ROPE};
        pg8::gemm_phase<pg8::EpiProj, pg8::StaticOrder, true, true>(ldsl, g, S, E);
    }
    GRID_SYNC();

    {
        PHASE_ARGS(); PHASE_TID();
        const float* lam_q1 = kp->in[5]; const float* lam_k1 = kp->in[6]; const float* lam_q2 = kp->in[7]; const float* lam_k2 = kp->in[8]; const float* g_sub = kp->in[9];
        bf16* OAB = (bf16*)(ws + WS_XN); bf16* PROJ = (bf16*)(ws + WS_PROJ);
        const float d1 = wave_sum(lam_q1[lane] * lam_k1[lane]), d2 = wave_sum(lam_q2[lane] * lam_k2[lane]);
        const float lam = __expf(d1) - __expf(d2) + 0.2f;
        for (int v = vcu; v < 256; v += G) {
            const int xg = v >> 5, j = v & 31;
            att::da_unit<false>(xg >> 2, xg & 3, j, PROJ, OAB, (char*)lds, lam, g_sub);
            att::da_issue_first((xg + 8) >> 2, (xg + 8) & 3, PROJ, (char*)lds);
            {
                KArgs kq = kp0; asm volatile("" : "+s"(kq)); unsigned char* wsq = kq->ws;
                const float* w_ba = kq->in[10]; const float* w_bb = kq->in[11]; const float* w_out = kq->in[14]; const float* g_ffn = kq->in[15]; const float* w_fg = kq->in[16]; const float* w_fu = kq->in[17]; const float* w_fd = kq->in[18];
                bf16* WABt = (bf16*)(wsq + WS_WAB); bf16* WOUTt = (bf16*)(wsq + WS_WOUT); bf16* WGUt = (bf16*)(wsq + WS_WGU); bf16* WDt = (bf16*)(wsq + WS_WD);
                LAS float* scr = (LAS float*)(ldsl + 65536 + wave * 8704);
                constexpr int I_WAB = 2 * 8 * 16, I_WOUT = 16 * 16, I_WGU = 16 * (NGU / 64), I_WD = (FF / 64) * 16, NDEF = I_WAB + I_WOUT + I_WGU + I_WD;
#define DEF_DECODE(IT, SRC, GK, DST, SRCN, COL, K0, D0, KK) do { int r = (IT); GK = nullptr; KK = 1024; \
                    if (r < I_WAB) { const int mat = r >> 7, rr = r & 127; K0 = 64 * (rr >> 4); D0 = 64 * (rr & 15); SRC = mat ? w_bb : w_ba; SRCN = 1024; COL = D0; DST = WABt + (mat ? 512 : 0); } \
                    else if ((r -= I_WAB) < I_WOUT) { K0 = 64 * (r >> 4); D0 = 64 * (r & 15); SRC = w_out; SRCN = 1024; COL = D0; DST = WOUTt; } \
                    else if ((r -= I_WOUT) < I_WGU) { const int nb = NGU / 64; K0 = 64 * (r / nb); D0 = 64 * (r % nb); const int tile = D0 >> 8, p = D0 & 255; COL = tile * 128 + (p & 127); SRC = (p >> 7) ? w_fu : w_fg; SRCN = FF; DST = WGUt; GK = g_ffn; } \
                    else { r -= I_WGU; K0 = 64 * (r >> 4); D0 = 64 * (r & 15); SRC = w_fd; SRCN = 1024; COL = D0; DST = WDt; KK = FF; } } while (0)
                int lane_g = lane; asm volatile("" : "+v"(lane_g));
                {
                    const int it0 = v * NWAVES + wave, it1 = it0 + 256 * NWAVES; const bool has1 = it1 < NDEF;
                    const float* srcA; const float* gkA; bf16* dstA; int snA, colA_, k0A, d0A, KA; f32x4 va[8], vb[8];
                    DEF_DECODE(it0, srcA, gkA, dstA, snA, colA_, k0A, d0A, KA);
                    trc_load(srcA, snA, colA_, k0A, va, lane_g); trc_load(srcA, snA, colA_, k0A + 32, vb, lane_g);
                    trc_proc(va, 0, k0A, dstA, KA, d0A, gkA, scr, lane_g);
                    if (has1) {
                        const float* srcB; const float* gkB; bf16* dstB; int snB, colB_, k0B, d0B, KB;
                        DEF_DECODE(it1, srcB, gkB, dstB, snB, colB_, k0B, d0B, KB);
                        trc_load(srcB, snB, colB_, k0B, va, lane_g);
                        trc_proc(vb, 1, k0A, dstA, KA, d0A, gkA, scr, lane_g);
                        trc_load(srcB, snB, colB_, k0B + 32, vb, lane_g);
                        trc_proc(va, 0, k0B, dstB, KB, d0B, gkB, scr, lane_g);
                        trc_proc(vb, 1, k0B, dstB, KB, d0B, gkB, scr, lane_g);
                    } else trc_proc(vb, 1, k0A, dstA, KA, d0A, gkA, scr, lane_g);
                }
#undef DEF_DECODE
                __syncthreads();
            }
            att::da_unit<true>((xg + 8) >> 2, (xg + 8) & 3, 31 - j, PROJ, OAB, (char*)lds, lam, g_sub);
        }
        for (int v = vcu; v < 256; v += G)
            for (int i = 0; i < 2; ++i) { const int id = v * 2 + i, bg = id >> 6, c = (i == 0) ? (id & 63) : 63 - ((id - 1) & 63); att::sb_unit(bg >> 1, bg & 1, c, PROJ, OAB, (char*)lds); }
    }
    GRID_SYNC();

    {
        PHASE_ARGS(); PHASE_TID();
        bf16* OAB = (bf16*)(ws + WS_XN); bf16* WABt = (bf16*)(ws + WS_WAB); bf16* MERGED = (bf16*)(ws + WS_MERGED); bf16* GATES = (bf16*)(ws + WS_GATES);
        pg8::Gemm g{OAB, WABt, M, D, D}; pg8::StaticOrder S; S.init(M, D, G, bx);
        pg8::EpiMerge E{MERGED, GATES};
        pg8::gemm_phase<pg8::EpiMerge, pg8::StaticOrder, true, true>(ldsl, g, S, E);
    }
    GROUP_SYNC();

    {
        PHASE_ARGS(); PHASE_TID();
        const float* x = kp->in[0]; float* SSQ = (float*)(ws + WS_SSQ); bf16* WOUTt = (bf16*)(ws + WS_WOUT); bf16* MERGED = (bf16*)(ws + WS_MERGED); bf16* X1B = (bf16*)(ws + WS_XN);
        pg8::Gemm g{MERGED, WOUTt, M, D, D}; pg8::StaticOrder S; S.init(M, D, G, bx);
        pg8::EpiWout E{x, X1B, SSQ};
        pg8::gemm_phase<pg8::EpiWout, pg8::StaticOrder, true, true>(ldsl, g, S, E);
    }
    GROUP_SYNC();

    {
        PHASE_ARGS(); PHASE_TID();
        float* SSQ = (float*)(ws + WS_SSQ); bf16* WGUt = (bf16*)(ws + WS_WGU); bf16* X1B = (bf16*)(ws + WS_XN); bf16* FFB = (bf16*)(ws + WS_FF);
        pg8::Gemm g{X1B, WGUt, M, NGU, D}; pg8::StaticOrder S; S.init(M, NGU, G, bx);
        pg8::EpiFfnUp E{FFB, SSQ};
        pg8::gemm_phase<pg8::EpiFfnUp, pg8::StaticOrder, true, true>(ldsl, g, S, E);
    }
    GROUP_SYNC();

    {
        PHASE_ARGS(); PHASE_TID();
        float* out = kp->out; bf16* WDt = (bf16*)(ws + WS_WD); bf16* FFB = (bf16*)(ws + WS_FF); const bf16* X1B = (const bf16*)(ws + WS_XN);
        pg8::Gemm g{FFB, WDt, M, D, FF}; pg8::StaticOrder S; S.init(M, D, G, bx);
        pg8::EpiDown E{out, X1B};
        pg8::gemm_phase<pg8::EpiDown, pg8::StaticOrder, true, true>(ldsl, g, S, E);
    }
}

extern "C" void kernel_launch(void* const* d_in, const int* in_sizes, int n_in, void* d_out, int out_size, void* d_ws, size_t ws_size, hipStream_t stream) {
    static int grid = 0;
    if (grid == 0) {
        if (n_in != 19 || in_sizes[0] != M * D || out_size != M * D || ws_size < WS_END) { fprintf(stderr, "kernel_launch: unexpected shapes (n_in %d, in0 %d, out %d, ws %zu); nothing launched\n", n_in, n_in > 0 ? in_sizes[0] : -1, out_size, ws_size); grid = -1; return; }
        int dev = 0, cus = 0, per_cu = 0;
        if (hipGetDevice(&dev) != hipSuccess || hipDeviceGetAttribute(&cus, hipDeviceAttributeMultiprocessorCount, dev) != hipSuccess) { grid = -1; return; }
        if (hipFuncSetAttribute((const void*)mk_fwd, hipFuncAttributeMaxDynamicSharedMemorySize, LDS_BYTES) != hipSuccess) { fprintf(stderr, "kernel_launch: hipFuncSetAttribute failed\n"); grid = -1; return; }
        if (hipOccupancyMaxActiveBlocksPerMultiprocessor(&per_cu, (const void*)mk_fwd, NWAVES * 64, LDS_BYTES) != hipSuccess || per_cu < 1) { (void)hipGetLastError(); per_cu = 1; }
        grid = cus * per_cu;
    }
    if (grid < 0) return;
    if (hipMemsetAsync(d_ws, 0, 32768, stream) != hipSuccess) { fprintf(stderr, "kernel_launch: hipMemsetAsync failed\n"); return; }
    Args a{};
    for (int i = 0; i < 19; ++i) a.in[i] = (const float*)d_in[i];
    a.out = (float*)d_out; a.ws = (unsigned char*)d_ws;
    void* kargs[] = {&a};
    const hipError_t e = hipLaunchCooperativeKernel((const void*)mk_fwd, dim3(grid), dim3(NWAVES * 64), kargs, LDS_BYTES, stream);
    if (e != hipSuccess) fprintf(stderr, "kernel_launch: cooperative launch failed: %s (grid %d)\n", hipGetErrorString(e), grid);
}
```
